# Optimizing an MI355X kernel written in HIP

```python
import math
import jax, jax.numpy as jnp
from jax import lax
import numpy as np

D_MODEL = 1024
BATCH = 2
SEQ = 8192
DEPTH = 2

GRID_W = 64
CTX_LEN = 256
N_MIXERS = 2
EXPAND = 2
E_HY = EXPAND * D_MODEL
FILTER_EMB = 33
FILTER_WIDTH = 64
DECAY_TARGET = 1e-2
FAST_DECAY_PCT = 0.3
SLOW_DECAY_PCT = 1.5
MAX_DECAY = math.log(DECAY_TARGET) / FAST_DECAY_PCT
MIN_DECAY = math.log(DECAY_TARGET) / SLOW_DECAY_PCT
HEAD_DIM = 128
N_HEADS = (EXPAND * D_MODEL) // HEAD_DIM
N_KV = N_HEADS // 4
GROUP = N_HEADS // N_KV
QD = N_HEADS * HEAD_DIM
KVD = N_KV * HEAD_DIM
ROPE_AXIS_DIM = HEAD_DIM // 2
ROPE_THETA = 10000.0
Q_BLOCK = 128
EPS = 1e-6

kernel_name = "hybrid_hyena_gqa_prefix_dit"


def rms_norm(x, g):
    xf = x.astype(jnp.float32)
    y = xf * lax.rsqrt(jnp.mean(xf * xf, axis=-1, keepdims=True) + EPS)
    return (y * g.astype(jnp.float32)).astype(x.dtype)


def short_conv(x, w, b):
    xp = jnp.pad(x, ((0, 0), (1, 1), (0, 0)))
    return xp[:, :-2] * w[0] + xp[:, 1:-1] * w[1] + xp[:, 2:] * w[2] + b


def hyena_filter(L, w1, b1, w2, b2, w3, b3, w4, freq):
    f32 = jnp.float32
    t = jnp.linspace(0.0, 1.0, L, dtype=f32)[:, None]
    bands = (FILTER_EMB - 1) // 2
    w = 2.0 * math.pi * jnp.arange(L, dtype=f32)[:, None] / L
    fr = jnp.linspace(1e-4, bands - 1, bands, dtype=f32)[None, :]
    z = jnp.concatenate([t, jnp.cos(fr * w), -jnp.sin(fr * w)], axis=-1)
    fq = freq.astype(f32)
    h = jnp.sin(fq * (z @ w1.astype(f32) + b1.astype(f32)))
    h = jnp.sin(fq * (h @ w2.astype(f32) + b2.astype(f32)))
    h = jnp.sin(fq * (h @ w3.astype(f32) + b3.astype(f32)))
    h = h @ w4.astype(f32)
    deltas = jnp.abs(jnp.linspace(MIN_DECAY, MAX_DECAY, E_HY, dtype=f32))
    decay = jnp.exp(-t * deltas[None, :])
    hf = h[:, :E_HY] * decay
    hb = h[:, E_HY:] * decay
    k = jnp.concatenate([hf, jnp.zeros((1, E_HY), f32), hb[:0:-1]], axis=0)
    return k / jnp.sum(jnp.abs(k), axis=0, keepdims=True)


def hyena_mixer(h, w_in, conv_w, conv_b, fw1, fb1, fw2, fb2, fw3, fb3, fw4, freq, d_skip, w_out):
    L = h.shape[1]
    proj = h @ w_in
    xv = short_conv(proj[..., :3 * E_HY], conv_w, conv_b)
    z = proj[..., 3 * E_HY:]
    x0, x1, v = jnp.split(xv, 3, axis=-1)
    u = x1 * v
    k = hyena_filter(L, fw1, fb1, fw2, fb2, fw3, fb3, fw4, freq)
    U = jnp.fft.rfft(u.astype(jnp.float32), n=2 * L, axis=1)
    K = jnp.fft.rfft(k, n=2 * L, axis=0)
    y = jnp.fft.irfft(U * K[None], n=2 * L, axis=1)[:, :L].astype(h.dtype)
    y = (y + u * d_skip) * x0
    return (y * jax.nn.silu(z)) @ w_out


def rope_half(x, ang):
    F = ang.shape[-1]
    shape = (ang.shape[0],) + (1,) * (x.ndim - 3) + (F,)
    cos = jnp.cos(ang).reshape(shape).astype(x.dtype)
    sin = jnp.sin(ang).reshape(shape).astype(x.dtype)
    x1, x2 = x[..., :F], x[..., F:]
    return jnp.concatenate([x1 * cos - x2 * sin, x1 * sin + x2 * cos], axis=-1)


def axial_rope(x, row_ang, col_ang):
    return jnp.concatenate([rope_half(x[..., :ROPE_AXIS_DIM], row_ang),
                            rope_half(x[..., ROPE_AXIS_DIM:], col_ang)], axis=-1)


def attend(q, k, v):
    s = jnp.einsum('bqkgd,bskd->bkgqs', q, k).astype(jnp.float32) * (HEAD_DIM ** -0.5)
    p = jax.nn.softmax(s, axis=-1).astype(v.dtype)
    return jnp.einsum('bkgqs,bskd->bqkgd', p, v)


def gqa_mixer(h_lat, h_ctx, w_in, q_g, k_g, w_out, want_ctx):
    B, L, _ = h_lat.shape
    C = h_ctx.shape[1]
    p = h_lat @ w_in
    q = rms_norm(p[..., :QD].reshape(B, L, N_KV, GROUP, HEAD_DIM), q_g)
    k = rms_norm(p[..., QD:QD + KVD].reshape(B, L, N_KV, HEAD_DIM), k_g)
    v = p[..., QD + KVD:QD + 2 * KVD].reshape(B, L, N_KV, HEAD_DIM)
    z = p[..., QD + 2 * KVD:]
    rows = L // GRID_W
    row = jnp.repeat(jnp.arange(rows, dtype=jnp.float32), GRID_W)
    col = jnp.tile(jnp.arange(GRID_W, dtype=jnp.float32), rows)
    inv = 1.0 / (ROPE_THETA ** (jnp.arange(0, ROPE_AXIS_DIM, 2, dtype=jnp.float32) / ROPE_AXIS_DIM))
    row_ang = row[:, None] * inv[None, :]
    col_ang = col[:, None] * inv[None, :]
    q = axial_rope(q, row_ang, col_ang)
    k = axial_rope(k, row_ang, col_ang)
    if want_ctx:
        pc = h_ctx @ w_in
    else:
        pc = h_ctx @ w_in[:, QD:QD + 2 * KVD]
        pc = jnp.pad(pc, ((0, 0), (0, 0), (QD, 0)))
    kc = rms_norm(pc[..., QD:QD + KVD].reshape(B, C, N_KV, HEAD_DIM), k_g)
    vc = pc[..., QD + KVD:QD + 2 * KVD].reshape(B, C, N_KV, HEAD_DIM)
    k_all = jnp.concatenate([k, kc], axis=1)
    v_all = jnp.concatenate([v, vc], axis=1)
    nb = L // Q_BLOCK
    qb = q.reshape(B, nb, Q_BLOCK, N_KV, GROUP, HEAD_DIM).transpose(1, 0, 2, 3, 4, 5)
    o = lax.map(lambda qq: attend(qq, k_all, v_all), qb)
    o = o.transpose(1, 0, 2, 3, 4, 5).reshape(B, L, QD)
    y_lat = (o * jax.nn.silu(z)) @ w_out
    if want_ctx:
        qc = rms_norm(pc[..., :QD].reshape(B, C, N_KV, GROUP, HEAD_DIM), q_g)
        oc = attend(qc, kc, vc).reshape(B, C, QD)
        y_ctx = (oc * jax.nn.silu(pc[..., QD + 2 * KVD:])) @ w_out
    else:
        y_ctx = None
    return y_lat, y_ctx


def setup_inputs(seed: int = 0) -> dict:
    key = jax.random.key(seed)
    ks = jax.random.split(key, 32)
    f32 = jnp.float32
    na = (DEPTH + 1) // 2
    nb = DEPTH // 2

    def nrm(k, shape, scale):
        return jax.random.normal(k, shape, f32) * scale

    return {
        "x": nrm(ks[0], (BATCH, SEQ, D_MODEL), 1.0),
        "c": nrm(ks[1], (BATCH, D_MODEL), 1.0),
        "ctx": nrm(ks[2], (BATCH, CTX_LEN, D_MODEL), 1.0),
        "c_ctx": nrm(ks[3], (D_MODEL,), 1.0),
        "norm_g": 1.0 + nrm(ks[4], (DEPTH, D_MODEL), 0.05),
        "ada_w": nrm(ks[5], (DEPTH, D_MODEL, 3 * D_MODEL), D_MODEL ** -0.5),
        "ada_b": nrm(ks[6], (DEPTH, 3 * D_MODEL), 0.02),
        "hy_w_in": nrm(ks[7], (na, D_MODEL, 4 * E_HY), D_MODEL ** -0.5),
        "hy_conv_w": nrm(ks[8], (na, 3, 3 * E_HY), 3 ** -0.5),
        "hy_conv_b": nrm(ks[9], (na, 3 * E_HY), 0.02),
        "hy_fw1": nrm(ks[10], (na, FILTER_EMB, FILTER_WIDTH), FILTER_EMB ** -0.5),
        "hy_fb1": nrm(ks[11], (na, FILTER_WIDTH), 0.02),
        "hy_fw2": nrm(ks[12], (na, FILTER_WIDTH, FILTER_WIDTH), FILTER_WIDTH ** -0.5),
        "hy_fb2": nrm(ks[13], (na, FILTER_WIDTH), 0.02),
        "hy_fw3": nrm(ks[14], (na, FILTER_WIDTH, FILTER_WIDTH), FILTER_WIDTH ** -0.5),
        "hy_fb3": nrm(ks[15], (na, FILTER_WIDTH), 0.02),
        "hy_fw4": nrm(ks[16], (na, FILTER_WIDTH, 2 * E_HY), FILTER_WIDTH ** -0.5),
        "hy_freq": 1.0 + nrm(ks[17], (na, FILTER_WIDTH), 0.05),
        "hy_d": nrm(ks[18], (na, E_HY), 0.5),
        "hy_w_out": nrm(ks[19], (na, E_HY, D_MODEL), E_HY ** -0.5),
        "at_w_in": nrm(ks[20], (nb, D_MODEL, 2 * QD + 2 * KVD), D_MODEL ** -0.5),
        "at_q_g": 1.0 + nrm(ks[21], (nb, HEAD_DIM), 0.05),
        "at_k_g": 1.0 + nrm(ks[22], (nb, HEAD_DIM), 0.05),
        "at_w_out": nrm(ks[23], (nb, QD, D_MODEL), QD ** -0.5),
    }


def reference(x, c, ctx, c_ctx, norm_g, ada_w, ada_b,
              hy_w_in, hy_conv_w, hy_conv_b, hy_fw1, hy_fb1, hy_fw2, hy_fb2, hy_fw3, hy_fb3,
              hy_fw4, hy_freq, hy_d, hy_w_out,
              at_w_in, at_q_g, at_k_g, at_w_out):
    sc_lat = jax.nn.silu(c)
    sc_ctx = jax.nn.silu(c_ctx)
    x_lat, x_ctx = x, ctx
    for i in range(DEPTH):
        last = i == DEPTH - 1
        mixer = i % N_MIXERS
        j = i // N_MIXERS
        need_ctx_in = (not last) or mixer == 1
        sh, sc, gt = jnp.split(sc_lat @ ada_w[i] + ada_b[i], 3, axis=-1)
        h_lat = rms_norm(x_lat, norm_g[i]) * (1.0 + sc[:, None]) + sh[:, None]
        if need_ctx_in:
            sh_c, sc_c, gt_c = jnp.split(sc_ctx @ ada_w[i] + ada_b[i], 3, axis=-1)
            h_ctx = rms_norm(x_ctx, norm_g[i]) * (1.0 + sc_c) + sh_c
        if mixer == 0:
            hp = (hy_w_in[j], hy_conv_w[j], hy_conv_b[j], hy_fw1[j], hy_fb1[j], hy_fw2[j], hy_fb2[j],
                  hy_fw3[j], hy_fb3[j], hy_fw4[j], hy_freq[j], hy_d[j], hy_w_out[j])
            y_lat = hyena_mixer(h_lat, *hp)
            y_ctx = None if last else hyena_mixer(h_ctx, *hp)
        else:
            y_lat, y_ctx = gqa_mixer(h_lat, h_ctx, at_w_in[j], at_q_g[j], at_k_g[j], at_w_out[j],
                                     not last)
        x_lat = x_lat + gt[:, None] * y_lat
        if not last:
            x_ctx = x_ctx + gt_c * y_ctx
    return x_lat
```

```cpp
#include <hip/hip_runtime.h>
#include <hip/hip_cooperative_groups.h>
#include <cstdio>
#include <cstdint>
namespace cg = cooperative_groups;

#define LAS __attribute__((address_space(3)))
typedef unsigned short bf16_t;
typedef float f32x4 __attribute__((ext_vector_type(4)));
typedef unsigned u32x4 __attribute__((ext_vector_type(4)));
typedef unsigned u32x2 __attribute__((ext_vector_type(2)));

constexpr int DM = 1024, LSEQ = 8192, NB = 2, CTX = 256, EH = 2048;
constexpr int MLAT = NB * LSEQ, MALL = MLAT + NB * CTX;
constexpr int SKV = LSEQ + CTX;
constexpr int NSTRIP = MALL / 64;
constexpr float MAX_DECAY = -15.350567286626973f, MIN_DECAY = -3.0701134573253945f;
constexpr float EPSN = 1e-6f;
constexpr int NTHR = 512;

constexpr size_t MiB = 1u << 20;
constexpr size_t WS_MOD = 1 * MiB;
constexpr size_t WS_H3 = 2 * MiB;
constexpr size_t WS_H3C = 4 * MiB;
constexpr size_t WS_ROPE = 5 * MiB;
constexpr size_t WS_KTC = 6 * MiB;
constexpr size_t WS_X1C = 10 * MiB;
constexpr size_t WS_WIN = 12 * MiB;
constexpr size_t WS_WOUT = 28 * MiB;
constexpr size_t WS_AWIN = 32 * MiB;
constexpr size_t WS_AWOUT = 42 * MiB;
constexpr size_t WS_H = 46 * MiB;
constexpr size_t WS_S = 79 * MiB;
constexpr size_t WS_UT = 112 * MiB;
constexpr size_t WS_G = 178 * MiB;
constexpr size_t WS_Q = 112 * MiB;
constexpr size_t WS_ZS = 176 * MiB;
constexpr size_t WS_KB = 79 * MiB;
constexpr size_t WS_VB = WS_KB + (size_t)NB * 4 * SKV * 128 * 2;
constexpr size_t WS_END = 244 * MiB;
static_assert(WS_VB + (size_t)NB * 4 * SKV * 128 * 2 <= WS_Q, "kv map");
static_assert(WS_ZS + (size_t)MLAT * 2048 * 2 <= WS_END, "zs map");

constexpr int LDS_BYTES = 147456;
constexpr int LDS_XCH = 131072;

__device__ __forceinline__ unsigned f2bf(float f) { unsigned u = __builtin_bit_cast(unsigned, f); return (u + 0x7fffu + ((u >> 16) & 1u)) >> 16; }
__device__ __forceinline__ float bf2f(unsigned short h) { return __builtin_bit_cast(float, (unsigned)h << 16); }
__device__ __forceinline__ unsigned pk2(float lo, float hi) { return f2bf(lo) | (f2bf(hi) << 16); }
__device__ __forceinline__ float silu_f(float z) { return z / (1.f + __expf(-z)); }
__device__ __forceinline__ float wave_sum(float v) {
#pragma unroll
    for (int o = 1; o < 64; o <<= 1) v += __shfl_xor(v, o);
    return v;
}
namespace pg8 {
#define PG8_LAS __attribute__((address_space(3)))
typedef short bf16x8 __attribute__((ext_vector_type(8)));
constexpr int BM = 256, BK = 64, HALF = 128, HTB = HALF * BK * 2  , STAGE_BYTES = 8 * HTB, NXCD = 8, WGM = 8;

__host__ __device__ __forceinline__ int lds_byte(int r, int c) { const int st = (r >> 4) * 2 + (c >> 5), rr = r & 15, cc = c & 31, ob = rr * 64 + cc * 2; return st * 1024 + (ob ^ (((ob >> 9) & 1) << 5)); }
__host__ __device__ __forceinline__ void stage_rc(int b, int& R, int& C) { const int st = b / 1024, sb = b % 1024, swz = sb ^ (((sb >> 9) & 1) << 5); R = (st >> 1) * 16 + swz / 64; C = (st & 1) * 32 + (swz % 64) / 2; }
__host__ __device__ __forceinline__ int perm32(int rho) { const int n = rho >> 4, i = rho & 15; return 8 * (i >> 2) + 4 * n + (i & 3); }

struct Unit { int pm, pn; };
struct Gemm { const bf16_t* A; const bf16_t* Bt; int M, N, K; };
struct StaticOrder {
    int nM, nN, nwg, G, c;
    __host__ __device__ void init(int M, int N, int G_, int c_) { nM = M / BM; nN = N / BM; nwg = nM * nN; G = G_; c = c_; }
    __host__ __device__ bool next(int i, Unit& u) const {
        const long L = (long)i * G + c; if (L >= nwg) return false;
        int wgid = (int)L; { const int q = nwg / NXCD, r = nwg % NXCD, xcd = wgid % NXCD, off = wgid / NXCD; wgid = (xcd < r ? xcd * (q + 1) : r * (q + 1) + (xcd - r) * q) + off; }
        const int nig = WGM * nN, gid = wgid / nig, fm = gid * WGM, gsz = (nM - fm) < WGM ? (nM - fm) : WGM;
        u.pm = fm + ((wgid % nig) % gsz); u.pn = (wgid % nig) / gsz; return true;
    }
    __device__ __forceinline__ void a_ready(const Unit&) const {}
    __device__ __forceinline__ void done(const Unit&) const {}
};
__device__ __forceinline__ unsigned cvt_pk_bf16(float lo, float hi) { unsigned r; asm volatile("v_cvt_pk_bf16_f32 %0, %1, %2" : "=v"(r) : "v"(lo), "v"(hi)); return r; }
typedef float f32x2 __attribute__((ext_vector_type(2)));
struct EpiHy {
    static constexpr bool PERM = true, AFTER_DRAIN = false;
    const float* cw; const float* cb; bf16_t* UT; bf16_t* G; float* S;
    __device__ __forceinline__ void operator()(const f32x4 (&acc)[2][2][4][2], const Unit& u, int wr, int wc, int fr, int fq) const {
        asm volatile("" : "+v"(fr), "+v"(fq));
        const int lane = fq * 16 + fr;
        const int c0 = u.pn * 64 + 16 * wc + 4 * fq;
        const int srcP = (lane & 48) | ((fr + 15) & 15), srcN = (lane & 48) | ((fr + 1) & 15);
        f32x4 w[3][3], bb[3];
#pragma unroll
        for (int s = 0; s < 3; ++s) { bb[s] = *(const f32x4*)(cb + s * 2048 + c0);
#pragma unroll
            for (int t = 0; t < 3; ++t) w[s][t] = *(const f32x4*)(cw + t * 6144 + s * 2048 + c0); }
#pragma unroll
        for (int ai = 0; ai < 2; ++ai) {
            const int strip = u.pm * 4 + ai * 2 + wr;
#pragma unroll
            for (int m = 0; m < 4; ++m) {
                f32x4 cv[3];
#pragma unroll
                for (int s = 0; s < 3; ++s) {
                    const f32x4 cur = acc[ai][s >> 1][m][s & 1];
                    const f32x4 up = acc[ai][s >> 1][m > 0 ? m - 1 : 0][s & 1];
                    const f32x4 dn = acc[ai][s >> 1][m < 3 ? m + 1 : 3][s & 1];
                    f32x4 pv, nx;
#pragma unroll
                    for (int j = 0; j < 4; ++j) { const float sp = (fr == 15) ? up[j] : cur[j], sn = (fr == 0) ? dn[j] : cur[j]; pv[j] = __shfl(sp, srcP); nx[j] = __shfl(sn, srcN); }
                    cv[s] = w[s][0] * pv + w[s][1] * cur + w[s][2] * nx + bb[s];
                }
                const f32x4 z = acc[ai][1][m][1];
                const bool interior = !((m == 0 && fr == 0) || (m == 3 && fr == 15));
                if (interior) {
                    const int row = strip * 64 + 16 * m + fr;
                    const f32x4 uu = cv[1] * cv[2];
                    f32x4 g;
#pragma unroll
                    for (int j = 0; j < 4; ++j) { g[j] = cv[0][j] * silu_f(z[j]); UT[(size_t)(c0 + j) * MALL + row] = (bf16_t)f2bf(uu[j]); }
                    u32x2 gw; gw.x = pk2(g[0], g[1]); gw.y = pk2(g[2], g[3]);
                    *(u32x2*)(G + (size_t)row * 2048 + c0) = gw;
                }
                __builtin_amdgcn_sched_barrier(0);
            }
            if (fr < 2) {
#pragma unroll
                for (int s = 0; s < 4; ++s) *(f32x4*)(S + ((size_t)((strip * 4 + fr) * 4 + s)) * 2048 + c0) = acc[ai][s >> 1][0][s & 1];
            }
            if (fr >= 14) {
#pragma unroll
                for (int s = 0; s < 4; ++s) *(f32x4*)(S + ((size_t)((strip * 4 + fr - 12) * 4 + s)) * 2048 + c0) = acc[ai][s >> 1][3][s & 1];
            }
        }
    }
};
struct EpiRes {
    static constexpr bool PERM = true, AFTER_DRAIN = false;
    const float* xlat; const float* xctx; float* olat; float* octx; const float* mod;
    __device__ __forceinline__ void operator()(const f32x4 (&acc)[2][2][4][2], const Unit& u, int wr, int wc, int fr, int fq) const {
        asm volatile("" : "+v"(fr), "+v"(fq));
        const int col0 = u.pn * 256 + wc * 32 + 8 * fq;
#pragma unroll
        for (int ai = 0; ai < 2; ++ai)
#pragma unroll
            for (int m = 0; m < 4; ++m) {
                const int row = u.pm * 256 + ai * 128 + wr * 64 + m * 16 + fr;
                const int src = row < LSEQ ? 0 : (row < MLAT ? 1 : 2);
                const float* xi; float* od;
                if (row < MLAT) { xi = xlat + (size_t)row * DM; od = olat + (size_t)row * DM; } else { xi = xctx + (size_t)(row - MLAT) * DM; od = octx + (size_t)(row - MLAT) * DM; }
                const float* gt = mod + src * 3072 + 2048;
#pragma unroll
                for (int bj = 0; bj < 2; ++bj) { const int col = col0 + bj * 128;
                    const f32x4 g0 = *(const f32x4*)(gt + col), g1 = *(const f32x4*)(gt + col + 4), x0 = *(const f32x4*)(xi + col), x1 = *(const f32x4*)(xi + col + 4);
                    *(f32x4*)(od + col) = x0 + g0 * acc[ai][bj][m][0]; *(f32x4*)(od + col + 4) = x1 + g1 * acc[ai][bj][m][1]; }
            }
    }
};
struct EpiQKV {
    static constexpr bool PERM = true, AFTER_DRAIN = false;
    const float* qg; const float* kg; const float* rope; bf16_t* Q; bf16_t* KB; bf16_t* VB; bf16_t* ZS; PG8_LAS float* xl;
    __device__ __forceinline__ void operator()(const f32x4 (&acc)[2][2][4][2], const Unit& u, int wr, int wc, int fr, int fq) const {
        asm volatile("" : "+v"(fr), "+v"(fq));
        const int pn = u.pn;
        if (pn < 10) {
            const bool isq = pn < 8;
#pragma unroll
            for (int ai = 0; ai < 2; ++ai)
#pragma unroll
                for (int m = 0; m < 4; ++m)
#pragma unroll
                    for (int bj = 0; bj < 2; ++bj) { const f32x4 a = acc[ai][bj][m][0], b = acc[ai][bj][m][1];
                        float s = (a[0] * a[0] + a[1] * a[1]) + (a[2] * a[2] + a[3] * a[3]) + (b[0] * b[0] + b[1] * b[1]) + (b[2] * b[2] + b[3] * b[3]);
                        s += __shfl_xor(s, 16); s += __shfl_xor(s, 32);
                        if (fq == 0) xl[((ai * 128 + wr * 64 + m * 16 + fr) * 2 + bj) * 4 + wc] = s; }
            asm volatile("s_waitcnt lgkmcnt(0)" ::: "memory"); __builtin_amdgcn_s_barrier(); asm volatile("" ::: "memory");
            const float* gg = isq ? qg : kg; const int d0 = 2 * (4 * wc + fq);
            float gv[2][4];
#pragma unroll
            for (int n = 0; n < 2; ++n)
#pragma unroll
                for (int j = 0; j < 4; ++j) gv[n][j] = gg[32 * (2 * n + (j >> 1)) + d0 + (j & 1)];
#pragma unroll
            for (int ai = 0; ai < 2; ++ai)
#pragma unroll
                for (int m = 0; m < 4; ++m) {
                    const int rl = ai * 128 + wr * 64 + m * 16 + fr, row = u.pm * 256 + rl;
                    const bool lat = row < MLAT; const int t = row & (LSEQ - 1);
                    const f32x4 rr = *(const f32x4*)(rope + ((t >> 6) * 32 + d0) * 2);
                    const f32x4 rc = *(const f32x4*)(rope + ((t & 63) * 32 + d0) * 2);
                    int bb_, ss_; if (lat) { bb_ = row >> 13; ss_ = t; } else { bb_ = (row - MLAT) >> 8; ss_ = LSEQ + ((row - MLAT) & 255); }
#pragma unroll
                    for (int bj = 0; bj < 2; ++bj) {
                        const f32x4 p4 = *(const PG8_LAS f32x4*)(xl + (rl * 2 + bj) * 4);
                        const float rinv = rsqrtf(((p4[0] + p4[1]) + (p4[2] + p4[3])) * (1.f / 128.f) + EPSN);
                        float y[2][4], o[2][4];
#pragma unroll
                        for (int n = 0; n < 2; ++n)
#pragma unroll
                            for (int j = 0; j < 4; ++j) y[n][j] = acc[ai][bj][m][n][j] * rinv * gv[n][j];
                        if (lat) {
#pragma unroll
                            for (int e = 0; e < 2; ++e) {
                                o[0][e] = y[0][e] * rr[2 * e] - y[0][2 + e] * rr[2 * e + 1]; o[0][2 + e] = y[0][e] * rr[2 * e + 1] + y[0][2 + e] * rr[2 * e];
                                o[1][e] = y[1][e] * rc[2 * e] - y[1][2 + e] * rc[2 * e + 1]; o[1][2 + e] = y[1][e] * rc[2 * e + 1] + y[1][2 + e] * rc[2 * e]; }
                        } else {
#pragma unroll
                            for (int n = 0; n < 2; ++n)
#pragma unroll
                                for (int j = 0; j < 4; ++j) o[n][j] = y[n][j];
                        }
                        u32x4 wv; wv.x = pk2(o[0][0], o[0][1]); wv.y = pk2(o[0][2], o[0][3]); wv.z = pk2(o[1][0], o[1][1]); wv.w = pk2(o[1][2], o[1][3]);
                        if (isq) { if (lat) *(u32x4*)(Q + (size_t)row * 2048 + (2 * pn + bj) * 128 + 32 * wc + 8 * fq) = wv; }
                        else { const int kvh = 2 * (pn - 8) + bj; *(u32x4*)(KB + ((size_t)(bb_ * 4 + kvh) * SKV + ss_) * 128 + 32 * wc + 8 * fq) = wv; }
                        __builtin_amdgcn_sched_barrier(0);
                    }
                }
        } else {
#pragma unroll
            for (int ai = 0; ai < 2; ++ai)
#pragma unroll
                for (int m = 0; m < 4; ++m) {
                    const int row = u.pm * 256 + ai * 128 + wr * 64 + m * 16 + fr;
                    const bool lat = row < MLAT; const int t = row & (LSEQ - 1);
                    int bb_, ss_; if (lat) { bb_ = row >> 13; ss_ = t; } else { bb_ = (row - MLAT) >> 8; ss_ = LSEQ + ((row - MLAT) & 255); }
#pragma unroll
                    for (int bj = 0; bj < 2; ++bj) {
                        f32x4 a = acc[ai][bj][m][0], b = acc[ai][bj][m][1];
                        if (pn < 12) {
                            u32x4 wv; wv.x = pk2(a[0], a[1]); wv.y = pk2(a[2], a[3]); wv.z = pk2(b[0], b[1]); wv.w = pk2(b[2], b[3]);
                            const int kvh = 2 * (pn - 10) + bj; *(u32x4*)(VB + ((size_t)(bb_ * 4 + kvh) * SKV + ss_) * 128 + 32 * wc + 8 * fq) = wv;
                        } else if (lat) {
#pragma unroll
                            for (int j = 0; j < 4; ++j) { a[j] = silu_f(a[j]); b[j] = silu_f(b[j]); }
                            u32x4 wv; wv.x = pk2(a[0], a[1]); wv.y = pk2(a[2], a[3]); wv.z = pk2(b[0], b[1]); wv.w = pk2(b[2], b[3]);
                            *(u32x4*)(ZS + (size_t)row * 2048 + (pn - 12) * 256 + bj * 128 + 32 * wc + 8 * fq) = wv;
                        }
                    }
                }
        }
    }
};
template <class Epi, class Sched, bool ALIGN_EPI = false, bool SP2 = false>
__device__ __forceinline__ void gemm_phase(PG8_LAS unsigned char* lds, const Gemm g, const Sched& S, const Epi& E, int tid_) {
    asm volatile("" : "+v"(tid_));
    const int tid = tid_, wid = __builtin_amdgcn_readfirstlane(tid >> 6), lane = tid & 63, wr = wid >> 2, wc = wid & 3, fr = lane & 15, fq = lane >> 4;
    const int K = g.K, nt = K / BK;
    unsigned voffA[2], voffB[2];
#pragma unroll
    for (int i = 0; i < 2; ++i) { int R, C; stage_rc(tid * 16 + i * 8192, R, C); const int Rb = Epi::PERM ? ((R & ~31) + perm32(R & 31)) : R;
        voffA[i] = (unsigned)(R * K + C) * 2u; voffB[i] = (unsigned)(Rb * K + C) * 2u; }
    const size_t kstep = (size_t)(BK * 2);
    const size_t hstep = (size_t)HALF * K * 2;
    const size_t tstep = 2 * hstep;
    const unsigned ldsw = (unsigned)wid * 1024u;
    const int aoff = lds_byte(wr * 64 + fr, fq * 8), boff = lds_byte(wc * 32 + fr, fq * 8);
#define PG8_SA(b, h) (((b) * 2 + (h)) * HTB)
#define PG8_SB(b, h) ((4 + (b) * 2 + (h)) * HTB)
#define PG8_STAGE(bufoff, gbase, voff) do { _Pragma("unroll") for (int _i = 0; _i < 2; ++_i) \
        __builtin_amdgcn_global_load_lds((const unsigned*)((const char*)(gbase) + (voff)[_i]), (PG8_LAS unsigned*)(lds + (bufoff) + ldsw + _i * 8192), 16, 0, 0); } while (0)
#define PG8_LDA(dst, b, h) do { _Pragma("unroll") for (int m = 0; m < 4; ++m) _Pragma("unroll") for (int k = 0; k < 2; ++k) dst[m][k] = *(const PG8_LAS bf16x8*)(lds + PG8_SA(b, h) + aoff + m * 2048 + k * 1024); } while (0)
#define PG8_LDB(dst, b, h) do { _Pragma("unroll") for (int n = 0; n < 2; ++n) _Pragma("unroll") for (int k = 0; k < 2; ++k) dst[n][k] = *(const PG8_LAS bf16x8*)(lds + PG8_SB(b, h) + boff + n * 2048 + k * 1024); } while (0)
#define PG8_MMA(ai, bj, At, Bt) do { __builtin_amdgcn_s_setprio(1); _Pragma("unroll") for (int m = 0; m < 4; ++m) _Pragma("unroll") for (int n = 0; n < 2; ++n) _Pragma("unroll") for (int k = 0; k < 2; ++k) \
        acc[ai][bj][m][n] = __builtin_amdgcn_mfma_f32_16x16x32_bf16(Bt[n][k], At[m][k], acc[ai][bj][m][n], 0, 0, 0); __builtin_amdgcn_s_setprio(0); } while (0)
#define PG8_WAIT_V(n) asm volatile("s_waitcnt vmcnt(" #n ")" ::: "memory")
#define PG8_WAIT_L(n) asm volatile("s_waitcnt lgkmcnt(" #n ")" ::: "memory")
#define PG8_BAR __builtin_amdgcn_s_barrier()
#define PG8_SCHED __builtin_amdgcn_sched_barrier(0)
    Unit cur, nxt; int ui = 0;
    if (!S.next(0, cur)) return;
    f32x4 acc[2][2][4][2];
#pragma unroll
    for (int a = 0; a < 2; ++a)
#pragma unroll
        for (int b = 0; b < 2; ++b)
#pragma unroll
            for (int m = 0; m < 4; ++m)
#pragma unroll
                for (int n = 0; n < 2; ++n) acc[a][b][m][n] = (f32x4){0.f, 0.f, 0.f, 0.f};
    bf16x8 At[4][2], B0[2][2], B1[2][2];
    const char* cA = (const char*)g.A + (size_t)cur.pm * tstep; const char* cB = (const char*)g.Bt + (size_t)cur.pn * tstep;
    S.a_ready(cur);
    if constexpr (SP2) {
        PG8_STAGE(PG8_SB(0, 0), cB, voffB); PG8_STAGE(PG8_SB(0, 1), cB + hstep, voffB); PG8_STAGE(PG8_SA(0, 0), cA, voffA); PG8_STAGE(PG8_SA(0, 1), cA + hstep, voffA);
        if (wr == 1) PG8_BAR;
        PG8_WAIT_V(2); PG8_BAR;
        PG8_STAGE(PG8_SB(1, 0), cB + kstep, voffB); PG8_STAGE(PG8_SA(1, 0), cA + kstep, voffA); PG8_STAGE(PG8_SB(1, 1), cB + hstep + kstep, voffB);
        PG8_WAIT_V(6); PG8_BAR;
    } else {
        PG8_STAGE(PG8_SB(0, 0), cB, voffB); PG8_STAGE(PG8_SA(0, 0), cA, voffA); PG8_STAGE(PG8_SB(0, 1), cB + hstep, voffB); PG8_STAGE(PG8_SA(0, 1), cA + hstep, voffA);
        if (wr == 1) PG8_BAR;
        PG8_WAIT_V(4); PG8_BAR;
        PG8_STAGE(PG8_SB(1, 0), cB + kstep, voffB); PG8_STAGE(PG8_SA(1, 0), cA + kstep, voffA); PG8_STAGE(PG8_SB(1, 1), cB + hstep + kstep, voffB);
        PG8_WAIT_V(6); PG8_BAR;
    }
    for (;;) {
        const bool has_next = S.next(ui + 1, nxt);
        const char* nA = has_next ? (const char*)g.A + (size_t)nxt.pm * tstep : cA; const char* nB = has_next ? (const char*)g.Bt + (size_t)nxt.pn * tstep : cB;
        for (int t = 0; t < nt; t += 2) {
            const bool last = (t == nt - 2);
            const char* a1 = cA + (size_t)(t + 1) * kstep;
            const char* a2 = last ? nA : cA + (size_t)(t + 2) * kstep; const char* b2 = last ? nB : cB + (size_t)(t + 2) * kstep;
            const char* a3 = a2 + kstep; const char* b3 = b2 + kstep;
            if (last && has_next) S.a_ready(nxt);
            if constexpr (SP2) {
            PG8_LDB(B0, 0, 0); PG8_LDB(B1, 0, 1); PG8_SCHED; PG8_LDA(At, 0, 0); PG8_STAGE(PG8_SA(1, 1), a1 + hstep, voffA);
            PG8_WAIT_V(8); PG8_WAIT_L(0); PG8_BAR; PG8_MMA(0, 0, At, B0); PG8_MMA(0, 1, At, B1); PG8_BAR; PG8_SCHED;
            PG8_LDA(At, 0, 1); PG8_STAGE(PG8_SB(0, 0), b2, voffB); PG8_STAGE(PG8_SB(0, 1), b2 + hstep, voffB); PG8_STAGE(PG8_SA(0, 0), a2, voffA);
            PG8_WAIT_V(8); PG8_WAIT_L(0); PG8_BAR; PG8_MMA(1, 0, At, B0); PG8_MMA(1, 1, At, B1); PG8_BAR; PG8_SCHED;
            PG8_LDB(B0, 1, 0); PG8_LDB(B1, 1, 1); PG8_SCHED; PG8_LDA(At, 1, 0); PG8_STAGE(PG8_SA(0, 1), a2 + hstep, voffA);
            PG8_WAIT_V(8); PG8_WAIT_L(0); PG8_BAR; PG8_MMA(0, 0, At, B0); PG8_MMA(0, 1, At, B1); PG8_BAR; PG8_SCHED;
            PG8_LDA(At, 1, 1); PG8_STAGE(PG8_SB(1, 0), b3, voffB); PG8_STAGE(PG8_SB(1, 1), b3 + hstep, voffB); PG8_STAGE(PG8_SA(1, 0), a3, voffA);
            PG8_WAIT_V(8); PG8_WAIT_L(0); PG8_BAR; PG8_MMA(1, 0, At, B0); PG8_MMA(1, 1, At, B1); PG8_BAR; PG8_SCHED;
            } else {
            PG8_LDB(B0, 0, 0); PG8_SCHED; PG8_LDA(At, 0, 0); PG8_STAGE(PG8_SA(1, 1), a1 + hstep, voffA);
            PG8_WAIT_L(8); PG8_BAR; PG8_WAIT_L(0); PG8_MMA(0, 0, At, B0); PG8_BAR; PG8_SCHED;
            PG8_LDB(B1, 0, 1); PG8_STAGE(PG8_SB(0, 0), b2, voffB);
            PG8_BAR; PG8_WAIT_L(0); PG8_MMA(0, 1, At, B1); PG8_BAR;
            PG8_LDA(At, 0, 1); PG8_STAGE(PG8_SA(0, 0), a2, voffA);
            PG8_BAR; PG8_WAIT_L(0); PG8_MMA(1, 0, At, B0); PG8_BAR; PG8_SCHED;
            PG8_STAGE(PG8_SB(0, 1), b2 + hstep, voffB);
            PG8_WAIT_V(6); PG8_BAR; PG8_MMA(1, 1, At, B1); PG8_BAR;
            PG8_LDB(B0, 1, 0); PG8_SCHED; PG8_LDA(At, 1, 0); PG8_STAGE(PG8_SA(0, 1), a2 + hstep, voffA);
            PG8_WAIT_L(8); PG8_BAR; PG8_WAIT_L(0); PG8_MMA(0, 0, At, B0); PG8_BAR; PG8_SCHED;
            PG8_LDB(B1, 1, 1); PG8_STAGE(PG8_SB(1, 0), b3, voffB);
            PG8_BAR; PG8_WAIT_L(0); PG8_MMA(0, 1, At, B1); PG8_BAR;
            PG8_LDA(At, 1, 1); PG8_STAGE(PG8_SA(1, 0), a3, voffA);
            PG8_BAR; PG8_WAIT_L(0); PG8_MMA(1, 0, At, B0); PG8_BAR; PG8_SCHED;
            PG8_STAGE(PG8_SB(1, 1), b3 + hstep, voffB);
            PG8_WAIT_V(6); PG8_BAR; PG8_MMA(1, 1, At, B1); PG8_BAR;
            }
        }
        if constexpr (ALIGN_EPI) { if (wr == 0) PG8_BAR; }
        if constexpr (!Epi::AFTER_DRAIN) { E(acc, cur, wr, wc, fr, fq); S.done(cur); }
        if (!has_next) break;
#pragma unroll
        for (int a = 0; a < 2; ++a)
#pragma unroll
            for (int b = 0; b < 2; ++b)
#pragma unroll
                for (int m = 0; m < 4; ++m)
#pragma unroll
                    for (int n = 0; n < 2; ++n) acc[a][b][m][n] = (f32x4){0.f, 0.f, 0.f, 0.f};
        cur = nxt; cA = nA; cB = nB; ++ui;
        if constexpr (ALIGN_EPI) { if (wr == 1) PG8_BAR; }
    }
    PG8_WAIT_V(0);
    if constexpr (!ALIGN_EPI) { if (wr == 0) PG8_BAR; }
    PG8_BAR;
    if constexpr (Epi::AFTER_DRAIN) { E.fused(acc, cur, wr, wc, fr, fq, lds, wid, lane); S.done(cur); }
#undef PG8_SA
#undef PG8_SB
#undef PG8_STAGE
#undef PG8_LDA
#undef PG8_LDB
#undef PG8_MMA
#undef PG8_WAIT_V
#undef PG8_WAIT_L
#undef PG8_BAR
#undef PG8_SCHED
}
}
namespace att {
typedef unsigned short bf16;
constexpr int   D = 128, NW = 8, QBLK = 32, KVBLK = 64;
constexpr float SCALE = 0.088388347648318440f;
constexpr float THR = 8.f;
constexpr int SDEPTH = 2;
constexpr int LDQ = 2048, LDK = 128, LDO = 2048;
constexpr size_t SHM_V = KVBLK * D * 2, SHM_K = KVBLK * D * 2, SHM_ATTN = 2 * SHM_V + 2 * SHM_K + NW * 64 * 4;
using bf16x8 = __attribute__((ext_vector_type(8))) short;
using s16x4  = __attribute__((ext_vector_type(4))) short;
using f32x16 = __attribute__((ext_vector_type(16))) float;
using f32x8  = __attribute__((ext_vector_type(8))) float;
using u32x4  = __attribute__((ext_vector_type(4))) unsigned;
#define KSWZ(row, colB) ((row) * 256 + ((colB) ^ (((row) & 7) << 4)))
#define SBAR() __builtin_amdgcn_sched_barrier(0)
__device__ __forceinline__ int crow(int r, int hi) { return (r & 3) + 8 * (r >> 2) + 4 * hi; }
__device__ __forceinline__ unsigned cvtpk(float lo, float hi) {
  unsigned r; asm volatile("v_cvt_pk_bf16_f32 %0, %1, %2" : "=v"(r) : "v"(lo), "v"(hi)); return r;
}
template <typename TIn> struct Stage;
template <> struct Stage<bf16>  { using T = bf16x8;
  __device__ static __forceinline__ T ld8(const bf16* p) { return *reinterpret_cast<const bf16x8*>(p); }
  __device__ static __forceinline__ bf16x8 tobf(T x) { return x; } };
__device__ __forceinline__ void partialSM(f32x16& p0, f32x16& p1, float& m_reg, float& mn, float& alpha) {
  constexpr float C = SCALE * 1.4426950408889634f;
  float pmax = p0[0]; for (int r = 1; r < 16; ++r) pmax = fmaxf(pmax, p0[r]); for (int r = 0; r < 16; ++r) pmax = fmaxf(pmax, p1[r]);
  { auto rr = __builtin_amdgcn_permlane32_swap(__float_as_uint(pmax), __float_as_uint(pmax), false, false);
    pmax = fmaxf(__uint_as_float(rr[0]), __uint_as_float(rr[1])); }
  if (__builtin_expect(__all(pmax - m_reg <= THR / SCALE), 1)) { mn = m_reg; alpha = 1.f; }
  else { mn = fmaxf(m_reg, pmax); alpha = __builtin_amdgcn_exp2f((m_reg - mn) * C); m_reg = mn; }
  float mnC = -mn * C;
  for (int r = 0; r < 16; ++r) p0[r] = fmaf(p0[r], C, mnC); for (int r = 0; r < 16; ++r) p1[r] = fmaf(p1[r], C, mnC);
  for (int r = 0; r < 16; ++r) p0[r] = __builtin_amdgcn_exp2f(p0[r]);
}
__device__ __forceinline__ void finishSM(f32x16& p0, f32x16& p1, float alpha, float& l_reg, bf16x8& pa0, bf16x8& pa1, bf16x8& pa2, bf16x8& pa3) {
  for (int r = 0; r < 16; ++r) p1[r] = __builtin_amdgcn_exp2f(p1[r]);
  float ps = 0; for (int r = 0; r < 16; ++r) ps += p0[r]; for (int r = 0; r < 16; ++r) ps += p1[r];
  { auto rr = __builtin_amdgcn_permlane32_swap(__float_as_uint(ps), __float_as_uint(ps), false, false);
    ps = __uint_as_float(rr[0]) + __uint_as_float(rr[1]); }
  l_reg = l_reg * alpha + ps;
#define PK4(P, BASE, OUT) do { unsigned a0 = cvtpk(P[BASE + 0], P[BASE + 1]), a1 = cvtpk(P[BASE + 2], P[BASE + 3]);   \
    unsigned b0 = cvtpk(P[BASE + 4], P[BASE + 5]), b1 = cvtpk(P[BASE + 6], P[BASE + 7]);                              \
    auto r0 = __builtin_amdgcn_permlane32_swap(a0, b0, false, false); auto r1 = __builtin_amdgcn_permlane32_swap(a1, b1, false, false); \
    u32x4 w = {r0[0], r1[0], r0[1], r1[1]}; OUT = *reinterpret_cast<bf16x8*>(&w); } while (0)
  PK4(p0, 0, pa0); PK4(p0, 8, pa1); PK4(p1, 0, pa2); PK4(p1, 8, pa3);
#undef PK4
}
__device__ __forceinline__ void qkt(f32x16& p0, f32x16& p1, const bf16* Ks, const bf16x8* qr, int r32, int hi) {
  p0 = f32x16{}; p1 = f32x16{};
  for (int d0 = 0; d0 < 8; ++d0) { int cb = (d0 * 16 + hi * 8) * 2;
    bf16x8 b0 = *reinterpret_cast<const bf16x8*>((const char*)Ks + KSWZ(r32, cb));
    bf16x8 b1 = *reinterpret_cast<const bf16x8*>((const char*)Ks + KSWZ(32 + r32, cb));
    p0 = __builtin_amdgcn_mfma_f32_32x32x16_bf16(b0, qr[d0], p0, 0, 0, 0);
    p1 = __builtin_amdgcn_mfma_f32_32x32x16_bf16(b1, qr[d0], p1, 0, 0, 0); }
}
__device__ __forceinline__ int v_st(int k, int c) { const int kk = (k & ~0xC) | ((k & 4) << 1) | ((k & 8) >> 1); return ((kk >> 3) * 4 + (c >> 5)) * 512 + ((kk & 7) * 32 + (c & 31)) * 2; }
__device__ __forceinline__ int v_rd_base(int lane) { return ((lane & 3) << 3) | (((lane >> 2) & 3) << 6) | (((lane >> 4) & 1) << 5) | (((lane >> 5) & 1) << 8); }
constexpr int v_rd_off(int d0, int ks, int half) { return d0 * 512 + ks * 4096 + half * 2048; }
template <int OFF> __device__ __forceinline__ s16x4 tr_read(int vb) {
  s16x4 r; asm volatile("ds_read_b64_tr_b16 %0, %1 offset:%2" : "=&v"(r) : "v"(vb), "i"(OFF) : "memory"); return r;
}
template <int D0> __device__ __forceinline__ void pv_one(f32x16& od, int vb, bf16x8 pa0, bf16x8 pa1, bf16x8 pa2, bf16x8 pa3) {
  const s16x4 l0 = tr_read<v_rd_off(D0, 0, 0)>(vb), h0 = tr_read<v_rd_off(D0, 0, 1)>(vb), l1 = tr_read<v_rd_off(D0, 1, 0)>(vb), h1 = tr_read<v_rd_off(D0, 1, 1)>(vb);
  const s16x4 l2 = tr_read<v_rd_off(D0, 2, 0)>(vb), h2 = tr_read<v_rd_off(D0, 2, 1)>(vb), l3 = tr_read<v_rd_off(D0, 3, 0)>(vb), h3 = tr_read<v_rd_off(D0, 3, 1)>(vb);
  asm volatile("s_waitcnt lgkmcnt(0)" ::: "memory"); SBAR();
#define PK(L, H) (bf16x8){L[0], L[1], L[2], L[3], H[0], H[1], H[2], H[3]}
  od = __builtin_amdgcn_mfma_f32_32x32x16_bf16(pa0, PK(l0, h0), od, 0, 0, 0);
  od = __builtin_amdgcn_mfma_f32_32x32x16_bf16(pa1, PK(l1, h1), od, 0, 0, 0);
  od = __builtin_amdgcn_mfma_f32_32x32x16_bf16(pa2, PK(l2, h2), od, 0, 0, 0);
  od = __builtin_amdgcn_mfma_f32_32x32x16_bf16(pa3, PK(l3, h3), od, 0, 0, 0);
#undef PK
}
__device__ __forceinline__ void pv_d0(f32x16* o, int vb, bf16x8 pa0, bf16x8 pa1, bf16x8 pa2, bf16x8 pa3) {
  pv_one<0>(o[0], vb, pa0, pa1, pa2, pa3); pv_one<1>(o[1], vb, pa0, pa1, pa2, pa3); pv_one<2>(o[2], vb, pa0, pa1, pa2, pa3); pv_one<3>(o[3], vb, pa0, pa1, pa2, pa3);
}
template <typename TQ>
__device__ __forceinline__ void attn_dense_body(const TQ* __restrict__ Qb, const bf16* __restrict__ Kh, const bf16* __restrict__ Vh,
                                                bf16* ZSb, int seq, char* lds, int tid_) {
  using St = Stage<bf16>; using SQ = Stage<TQ>;
  asm volatile("" : "+v"(tid_));
  const int tid = tid_, wid = tid >> 6, lane = tid & 63, r32 = lane & 31, hi = lane >> 5;
  bf16* V_lds = (bf16*)lds; bf16* K_lds = (bf16*)(lds + 2 * SHM_V);
  float* ws = (float*)(lds + 2 * SHM_V + 2 * SHM_K) + wid * 64; float* li_l = ws; float* al_l = ws + 32;
  float m_reg = -1e30f, l_reg = 0; f32x16 o[4] = {}; bf16x8 qr[8];
  const TQ* Qw = Qb + (long)(wid * QBLK + r32) * LDQ + hi * 8;
#pragma unroll
  for (int d0 = 0; d0 < 8; ++d0) qr[d0] = SQ::tobf(SQ::ld8(Qw + d0 * 16));
  const int sr = tid >> 4, sc = (tid & 15) * 8, vst0 = v_st(sr, sc), vst1 = v_st(32 + sr, sc);
  const int vb0 = (int)(uintptr_t)V_lds + v_rd_base(lane);
  struct { typename St::T vs0, vs1, ks0, ks1; } sr_[SDEPTH];
#define SLOAD(i, k0) do { sr_[i].vs0 = St::ld8(&Vh[(long)((k0) + sr) * LDK + sc]); sr_[i].vs1 = St::ld8(&Vh[(long)((k0) + 32 + sr) * LDK + sc]); \
    sr_[i].ks0 = St::ld8(&Kh[(long)((k0) + sr) * LDK + sc]); sr_[i].ks1 = St::ld8(&Kh[(long)((k0) + 32 + sr) * LDK + sc]); } while (0)
#define SWRITE(b, i) do { *(bf16x8*)((char*)V_lds + (b) * SHM_V + vst0) = St::tobf(sr_[i].vs0);          \
    *(bf16x8*)((char*)V_lds + (b) * SHM_V + vst1) = St::tobf(sr_[i].vs1); int kc = sc * 2;               \
    *(bf16x8*)((char*)K_lds + (b) * SHM_K + KSWZ(sr, kc)) = St::tobf(sr_[i].ks0);                       \
    *(bf16x8*)((char*)K_lds + (b) * SHM_K + KSWZ(32 + sr, kc)) = St::tobf(sr_[i].ks1); } while (0)
#define SWAIT() do { if constexpr (SDEPTH == 2) asm volatile("s_waitcnt vmcnt(4)" ::: "memory"); else asm volatile("s_waitcnt vmcnt(0)" ::: "memory"); } while (0)
#define RESC(a) do { if (__any((a) < 1.f)) { if (hi == 0) al_l[r32] = (a); asm volatile("s_waitcnt lgkmcnt(0)" ::: "memory"); \
    for (int d = 0; d < 4; ++d) for (int r = 0; r < 16; ++r) o[d][r] *= al_l[crow(r, hi)]; } } while (0)
  f32x16 pA0, pA1, pB0, pB1; float mnA, mnB, alA, alB; bf16x8 pa0, pa1, pa2, pa3; const int NT = seq / KVBLK;
  constexpr int SE = 0, SO = SDEPTH - 1;
  SLOAD(SE, 0); asm volatile("s_waitcnt vmcnt(0)" ::: "memory"); SWRITE(0, SE); __syncthreads();
  qkt(pA0, pA1, K_lds, qr, r32, hi); partialSM(pA0, pA1, m_reg, mnA, alA);
  SLOAD(SO, KVBLK); if constexpr (SDEPTH == 2) { if (2 < NT) SLOAD(SE, 2 * KVBLK); }
  SWAIT(); SWRITE(1, SO); __syncthreads();
  for (int j = 1; j + 1 < NT; j += 2) {
    SBAR(); qkt(pB0, pB1, (bf16*)((char*)K_lds + SHM_K), qr, r32, hi);
    finishSM(pA0, pA1, alA, l_reg, pa0, pa1, pa2, pa3); SBAR();
    SLOAD(SO, (j + SDEPTH) * KVBLK); SBAR();
    pv_d0(o, vb0, pa0, pa1, pa2, pa3); partialSM(pB0, pB1, m_reg, mnB, alB);
    __syncthreads(); SWAIT(); SWRITE(0, SE);
    RESC(alB); __syncthreads();
    SBAR(); qkt(pA0, pA1, K_lds, qr, r32, hi);
    finishSM(pB0, pB1, alB, l_reg, pa0, pa1, pa2, pa3); SBAR();
    if (SDEPTH == 1 || j + 3 < NT) SLOAD(SE, (j + 1 + SDEPTH) * KVBLK); SBAR();
    pv_d0(o, vb0 + (int)SHM_V, pa0, pa1, pa2, pa3); partialSM(pA0, pA1, m_reg, mnA, alA);
    __syncthreads(); SWAIT(); SWRITE(1, SO);
    RESC(alA); __syncthreads();
  }
  SBAR(); qkt(pB0, pB1, (bf16*)((char*)K_lds + SHM_K), qr, r32, hi);
  finishSM(pA0, pA1, alA, l_reg, pa0, pa1, pa2, pa3); SBAR();
  pv_d0(o, vb0, pa0, pa1, pa2, pa3); partialSM(pB0, pB1, m_reg, mnB, alB);
  __syncthreads(); RESC(alB);
  finishSM(pB0, pB1, alB, l_reg, pa0, pa1, pa2, pa3); SBAR();
  pv_d0(o, vb0 + (int)SHM_V, pa0, pa1, pa2, pa3);
  if (hi == 0) li_l[r32] = l_reg; asm volatile("s_waitcnt lgkmcnt(0)" ::: "memory");
  float rli[16];
#pragma unroll
  for (int r = 0; r < 16; ++r) rli[r] = __builtin_amdgcn_rcpf(li_l[crow(r, hi)]);
  bf16* Zw = ZSb + (long)(wid * QBLK) * LDO;
#pragma unroll
  for (int r = 0; r < 16; ++r) { int orow = crow(r, hi);
    for (int d0 = 0; d0 < 4; ++d0) { bf16* zp = Zw + (long)orow * LDO + d0 * 32 + r32; const float zs = __builtin_bit_cast(float, (unsigned)(*zp) << 16);
      const float a2 = o[d0][r] * rli[r] * zs; unsigned ub = __builtin_bit_cast(unsigned, a2); *zp = (bf16)((ub + 0x7fffu + ((ub >> 16) & 1u)) >> 16); } }
  __syncthreads();
#undef SLOAD
#undef SWRITE
#undef SWAIT
#undef RESC
}
}
struct Args {
    const float *x, *c, *ctx, *c_ctx, *norm_g, *ada_w, *ada_b, *hy_w_in, *hy_conv_w, *hy_conv_b, *fw1, *fb1, *fw2, *fb2, *fw3, *fb3, *fw4, *freq, *hy_d, *hy_w_out,
                *at_w_in, *at_q_g, *at_k_g, *at_w_out;
    float* out; unsigned char* ws;
};

template <int MODE> __device__ __forceinline__ int dest_row(int n) {
    if (MODE == 1) { const int s = n >> 11, c = n & 2047, pn = c >> 6, cl = c & 63; return pn * 256 + 128 * (s >> 1) + 32 * (cl >> 4) + 8 * ((cl >> 2) & 3) + 4 * (s & 1) + (cl & 3); }
    if (MODE == 2) { if (n >= 2560) return n; const int hh = n >> 7, dim = n & 127, quarter = dim >> 5, rem = dim & 31;
        return hh * 128 + 32 * (rem >> 3) + 8 * ((rem >> 1) & 3) + 4 * (quarter >> 1) + 2 * (quarter & 1) + (rem & 1); }
    return n;
}
template <int MODE> __device__ __forceinline__ void transpose_item(const float* W, int K, int N, bf16_t* WT, LAS float* scr, int item, int lane) {
    const int nblk = N / 32, kb = item / nblk, nb = item % nblk, k0 = 64 * kb, n0 = 32 * nb;
#pragma unroll 8
    for (int i = 0; i < 32; ++i) { const int kk = 2 * i + (lane >> 5); scr[kk * 33 + (lane & 31)] = W[(size_t)(k0 + kk) * N + n0 + (lane & 31)]; }
    asm volatile("s_waitcnt lgkmcnt(0)" ::: "memory");
    const int c = lane & 7;
#pragma unroll
    for (int j = 0; j < 4; ++j) { const int n = (lane >> 3) + 8 * j; const LAS float* s = scr + (8 * c) * 33 + n;
        u32x4 o; o.x = pk2(s[0 * 33], s[1 * 33]); o.y = pk2(s[2 * 33], s[3 * 33]); o.z = pk2(s[4 * 33], s[5 * 33]); o.w = pk2(s[6 * 33], s[7 * 33]);
        *(u32x4*)(WT + (size_t)dest_row<MODE>(n0 + n) * K + k0 + 8 * c) = o; }
    asm volatile("s_waitcnt lgkmcnt(0)" ::: "memory");
}
__device__ __forceinline__ float red_rev(float x) { const float n = rintf(x * 0.15915494309189535f); float r = fmaf(n, -6.28125f, x); r = fmaf(n, -0.0019353071795864769f, r); return r * 0.15915494309189535f; }
__device__ __forceinline__ float hsin(float x) { return __builtin_amdgcn_sinf(red_rev(x)); }
__device__ __forceinline__ float hcos(float x) { return __builtin_amdgcn_cosf(red_rev(x)); }
__device__ __forceinline__ float rdlane(float v, int k) { return __builtin_bit_cast(float, __builtin_amdgcn_readlane(__builtin_bit_cast(int, v), k)); }
__device__ __forceinline__ void filt_item(const Args& A, int L, int i, float* h3row, int lane) {
    const float t = (float)i / (float)(L - 1);
    const float w = 6.283185307179586f * (float)i / (float)L;
    float zf = 0.f;
    if (lane == 0) zf = t;
    else if (lane <= 32) { const int mi = (lane - 1) & 15; const float fr = 1e-4f + (float)mi * ((15.0f - 1e-4f) / 15.0f); zf = (lane <= 16) ? hcos(fr * w) : -hsin(fr * w); }
    const float fq = A.freq[lane];
    float a = A.fb1[lane];
#pragma unroll 3
    for (int k = 0; k < 33; ++k) a += rdlane(zf, k) * A.fw1[k * 64 + lane];
    float h = hsin(fq * a);
    a = A.fb2[lane];
#pragma unroll 8
    for (int k = 0; k < 64; ++k) a += rdlane(h, k) * A.fw2[k * 64 + lane];
    h = hsin(fq * a);
    a = A.fb3[lane];
#pragma unroll 8
    for (int k = 0; k < 64; ++k) a += rdlane(h, k) * A.fw3[k * 64 + lane];
    h = hsin(fq * a);
    h3row[lane] = h;
}
__device__ __forceinline__ void norm_row(const float* xrow, const float* g, const float* mod, bf16_t* orow, int lane) {
    const f32x4* xr = (const f32x4*)xrow + lane;
    f32x4 v[4]; float s = 0.f;
#pragma unroll
    for (int j = 0; j < 4; ++j) { v[j] = xr[64 * j]; s += (v[j].x * v[j].x + v[j].y * v[j].y) + (v[j].z * v[j].z + v[j].w * v[j].w); }
    const float rstd = rsqrtf(wave_sum(s) * (1.f / DM) + EPSN);
#pragma unroll
    for (int j = 0; j < 4; ++j) { const int col = 4 * lane + 256 * j;
        const f32x4 gg = *(const f32x4*)(g + col), sh = *(const f32x4*)(mod + col), sc = *(const f32x4*)(mod + 1024 + col);
        const f32x4 h = v[j] * rstd * gg * (1.f + sc) + sh;
        u32x2 o; o.x = pk2(h.x, h.y); o.y = pk2(h.z, h.w); *(u32x2*)(orow + col) = o; }
}

typedef float cf __attribute__((ext_vector_type(2)));
__device__ __forceinline__ cf cmul(cf a, cf b) { return {a.x * b.x - a.y * b.y, a.x * b.y + a.y * b.x}; }
template <int SGN> __device__ __forceinline__ cf mulw4(cf a) { return SGN > 0 ? cf{-a.y, a.x} : cf{a.y, -a.x}; }
template <int SGN> __device__ __forceinline__ void fft4(cf& a0, cf& a1, cf& a2, cf& a3) {
    const cf s02 = a0 + a2, d02 = a0 - a2, s13 = a1 + a3, d13 = mulw4<SGN>(a1 - a3);
    a0 = s02 + s13; a1 = d02 + d13; a2 = s02 - s13; a3 = d02 - d13;
}
template <int SGN> __device__ __forceinline__ cf tw(float frac) { return {__builtin_amdgcn_cosf(frac), (float)SGN * __builtin_amdgcn_sinf(frac)}; }
template <int SGN> __device__ __forceinline__ void fft16(cf (&v)[16]) {
#pragma unroll
    for (int b = 0; b < 4; ++b) fft4<SGN>(v[b], v[4 + b], v[8 + b], v[12 + b]);
    constexpr float C1 = 0.92387953251128674f, S1 = 0.38268343236508977f, C2 = 0.70710678118654752f;
    const float sg = (float)SGN;
    v[4 * 1 + 1] = cmul(v[4 * 1 + 1], cf{C1, sg * S1});
    v[4 * 1 + 2] = cmul(v[4 * 1 + 2], cf{C2, sg * C2});
    v[4 * 1 + 3] = cmul(v[4 * 1 + 3], cf{S1, sg * C1});
    v[4 * 2 + 1] = cmul(v[4 * 2 + 1], cf{C2, sg * C2});
    v[4 * 2 + 2] = mulw4<SGN>(v[4 * 2 + 2]);
    v[4 * 2 + 3] = cmul(v[4 * 2 + 3], cf{-C2, sg * C2});
    v[4 * 3 + 1] = cmul(v[4 * 3 + 1], cf{S1, sg * C1});
    v[4 * 3 + 2] = cmul(v[4 * 3 + 2], cf{-C2, sg * C2});
    v[4 * 3 + 3] = cmul(v[4 * 3 + 3], cf{-C1, -sg * S1});
#pragma unroll
    for (int c = 0; c < 4; ++c) fft4<SGN>(v[4 * c + 0], v[4 * c + 1], v[4 * c + 2], v[4 * c + 3]);
}
template <int SGN> __device__ __forceinline__ void fft_run(cf (&v)[32], LAS cf* L, int tid) {
    asm volatile("" : "+v"(tid));
    const int pb = tid + (tid >> 4);
#pragma unroll
    for (int i = 0; i < 2; ++i) { cf t[16];
#pragma unroll
        for (int q = 0; q < 16; ++q) t[q] = v[i + 2 * q];
        fft16<SGN>(t); LAS cf* Lw = L + 17 * tid + 8704 * i;
#pragma unroll
        for (int p = 0; p < 16; ++p) Lw[p] = t[4 * (p & 3) + (p >> 2)];
        asm volatile("" ::: "memory"); __builtin_amdgcn_sched_barrier(0); }
    __syncthreads();
#pragma unroll
    for (int ps = 0; ps < 2; ++ps) { const int Ns = ps ? 256 : 16;
#pragma unroll
        for (int i = 0; i < 2; ++i)
#pragma unroll
            for (int q = 0; q < 16; ++q) v[i * 16 + q] = L[pb + 544 * i + 1088 * q];
        __syncthreads();
#pragma unroll
        for (int i = 0; i < 2; ++i) { const int j = tid + 512 * i, jm = j & (Ns - 1); const float f1 = (float)jm / (float)(Ns * 16);
            cf t[16]; t[0] = v[i * 16];
#pragma unroll
            for (int q = 1; q < 16; ++q) t[q] = cmul(v[i * 16 + q], tw<SGN>(f1 * (float)q));
            fft16<SGN>(t); const int base = (j / Ns) * Ns * 16 + jm; LAS cf* Lw = L + base + (base >> 4);
#pragma unroll
            for (int p = 0; p < 16; ++p) Lw[(Ns + (Ns >> 4)) * p] = t[4 * (p & 3) + (p >> 2)];
            asm volatile("" ::: "memory"); __builtin_amdgcn_sched_barrier(0); }
        __syncthreads();
    }
#pragma unroll
    for (int i = 0; i < 8; ++i) { const int j = tid + 512 * i; const float f1 = (float)j * (1.0f / 16384.0f);
        cf a0 = L[pb + 544 * i], a1 = L[pb + 544 * i + 4352], a2 = L[pb + 544 * i + 8704], a3 = L[pb + 544 * i + 13056];
        a1 = cmul(a1, tw<SGN>(f1)); a2 = cmul(a2, tw<SGN>(2.f * f1)); a3 = cmul(a3, tw<SGN>(3.f * f1));
        fft4<SGN>(a0, a1, a2, a3); v[i] = a0; v[i + 8] = a1; v[i + 16] = a2; v[i + 24] = a3; if (i & 1) __builtin_amdgcn_sched_barrier(0); }
    __syncthreads();
}
__device__ __forceinline__ float block_sum(float v, LAS float* red, int tid) {
    v = wave_sum(v);
    if ((tid & 63) == 0) red[tid >> 6] = v;
    __syncthreads();
    float s = 0.f;
#pragma unroll
    for (int i = 0; i < 8; ++i) s += red[i];
    __syncthreads();
    return s;
}
#ifndef PH
#define PH 0x7ff
#endif
__device__ __forceinline__ const Args& kargs_ref() {
#if defined(__HIP_DEVICE_COMPILE__)
    typedef const __attribute__((address_space(4))) Args* KArgP;
    KArgP p = (KArgP)__builtin_amdgcn_kernarg_segment_ptr(); asm volatile("" : "+s"(p)); return *(const Args*)p;
#else
    static Args dummy; return dummy;
#endif
}
__global__ void __launch_bounds__(NTHR, 2) mk_fwd(Args Akern) {
    extern __shared__ __attribute__((aligned(16))) unsigned char lds_raw[];
    cg::grid_group grid = cg::this_grid();
    LAS unsigned char* lds = (LAS unsigned char*)lds_raw;
    const int G = gridDim.x, bx = blockIdx.x;
    const int wave_s = __builtin_amdgcn_readfirstlane((int)threadIdx.x >> 6);
#define MOD ((float*)(ws + WS_MOD))
#define H3 ((float*)(ws + WS_H3))
#define H3C ((float*)(ws + WS_H3C))
#define ROPE ((float*)(ws + WS_ROPE))
#define KTC ((float*)(ws + WS_KTC))
#define X1C ((float*)(ws + WS_X1C))
#define WIN ((bf16_t*)(ws + WS_WIN))
#define WOUT ((bf16_t*)(ws + WS_WOUT))
#define AWIN ((bf16_t*)(ws + WS_AWIN))
#define AWOUT ((bf16_t*)(ws + WS_AWOUT))
#define H ((bf16_t*)(ws + WS_H))
#define S ((float*)(ws + WS_S))
#define UT ((bf16_t*)(ws + WS_UT))
#define GB ((bf16_t*)(ws + WS_G))
#define Q ((bf16_t*)(ws + WS_Q))
#define ZS ((bf16_t*)(ws + WS_ZS))
#define KB ((bf16_t*)(ws + WS_KB))
#define VB ((bf16_t*)(ws + WS_VB))
#define KT ((bf16_t*)A.out)
    if constexpr ((PH >> 0) & 1) {
        const Args& A = kargs_ref(); unsigned char* ws = A.ws; int tid_; asm volatile("v_mbcnt_lo_u32_b32 %0, -1, 0\n\tv_mbcnt_hi_u32_b32 %0, -1, %0" : "=v"(tid_)); tid_ += wave_s * 64; const int tid = tid_, lane = tid & 63, wave = __builtin_amdgcn_readfirstlane(tid >> 6), gw = bx * 8 + wave, NGW = G * 8; (void)lane; (void)gw; (void)NGW;
        LAS float* scr = (LAS float*)(lds + wave * 8448);
        constexpr int I0 = 16 * 256, I1 = 16 * 160, I2 = 32 * 32, I3 = 32 * 32;
        for (int it = gw; it < I0 + I1 + I2 + I3; it += NGW) {
            int r = it;
            if (r < I0) { transpose_item<1>(A.hy_w_in, 1024, 8192, WIN, scr, r, lane); continue; } r -= I0;
            if (r < I1) { transpose_item<2>(A.at_w_in, 1024, 5120, AWIN, scr, r, lane); continue; } r -= I1;
            if (r < I2) { transpose_item<0>(A.hy_w_out, 2048, 1024, WOUT, scr, r, lane); continue; } r -= I2;
            transpose_item<0>(A.at_w_out, 2048, 1024, AWOUT, scr, r, lane);
        }
        for (int it = gw; it < LSEQ + CTX; it += NGW) { if (it < LSEQ) filt_item(A, LSEQ, it, H3 + (size_t)it * 64, lane); else filt_item(A, CTX, it - LSEQ, H3C + (size_t)(it - LSEQ) * 64, lane); }
        for (int it = bx * NTHR + tid; it < 128 * 32; it += G * NTHR) { const int pos = it >> 5, f = it & 31; const float inv = __builtin_amdgcn_exp2f(-(float)f * (13.287712379549449f / 32.0f)); const float ang = (float)pos * inv;
            ROPE[it * 2] = hcos(ang); ROPE[it * 2 + 1] = hsin(ang); }
        __syncthreads();
        LAS float* part = (LAS float*)lds;
        for (int it = bx; it < 96; it += G) {
            const int l = it / 48, n = (it % 48) * 64 + lane;
            const float* W = A.ada_w + (size_t)l * 1024 * 3072 + n;
            float a0 = 0.f, a1 = 0.f, a2 = 0.f;
#pragma unroll 8
            for (int k = wave * 128; k < wave * 128 + 128; ++k) { const float wv = W[(size_t)k * 3072];
                a0 += silu_f(A.c[k]) * wv; a1 += silu_f(A.c[1024 + k]) * wv; a2 += silu_f(A.c_ctx[k]) * wv; }
            part[(wave * 3 + 0) * 64 + lane] = a0; part[(wave * 3 + 1) * 64 + lane] = a1; part[(wave * 3 + 2) * 64 + lane] = a2;
            __syncthreads();
            if (wave < 3) { float s = A.ada_b[l * 3072 + n];
#pragma unroll
                for (int w8 = 0; w8 < 8; ++w8) s += part[(w8 * 3 + wave) * 64 + lane];
                MOD[(l * 3 + wave) * 3072 + n] = s; }
            __syncthreads();
        }
    }
    grid.sync();
    if constexpr ((PH >> 1) & 1) {
        const Args& A = kargs_ref(); unsigned char* ws = A.ws; int tid_; asm volatile("v_mbcnt_lo_u32_b32 %0, -1, 0\n\tv_mbcnt_hi_u32_b32 %0, -1, %0" : "=v"(tid_)); tid_ += wave_s * 64; const int tid = tid_, lane = tid & 63, wave = __builtin_amdgcn_readfirstlane(tid >> 6), gw = bx * 8 + wave, NGW = G * 8; (void)lane; (void)gw; (void)NGW;
        for (int m = gw; m < MALL; m += NGW) { const int src = m < LSEQ ? 0 : (m < MLAT ? 1 : 2);
            const float* xr = m < MLAT ? A.x + (size_t)m * DM : A.ctx + (size_t)(m - MLAT) * DM;
            norm_row(xr, A.norm_g, MOD + src * 3072, H + (size_t)m * DM, lane); }
        LAS float* Wl = (LAS float*)lds;
        for (int it = bx; it < 256 + 16; it += G) {
            const bool isctx = it >= 256; const int cgp = isctx ? it - 256 : (it & 15), tb = isctx ? 0 : (it >> 4);
            __syncthreads();
            for (int e = tid; e < 64 * 256; e += NTHR) { const int k = e >> 8, col = e & 255; Wl[col * 68 + k] = A.fw4[(size_t)k * 4096 + cgp * 256 + col]; }
            __syncthreads();
            const int L = isctx ? CTX : LSEQ; const int t = isctx ? (tid & 255) : tb * 512 + tid;
            const float* hsrc = (isctx ? H3C : H3) + (size_t)t * 64;
            f32x4 hr[16];
#pragma unroll
            for (int k4 = 0; k4 < 16; ++k4) hr[k4] = *(const f32x4*)(hsrc + 4 * k4);
            const float tn = (float)t / (float)(L - 1);
            const int cbeg = isctx ? (tid >> 8) * 128 : 0, ncol = isctx ? 128 : 256;
            for (int cc = cbeg; cc < cbeg + ncol; ++cc) {
                f32x4 a4 = {0.f, 0.f, 0.f, 0.f};
#pragma unroll
                for (int k4 = 0; k4 < 16; ++k4) a4 += hr[k4] * *(const LAS f32x4*)(Wl + cc * 68 + 4 * k4);
                const float a = (a4.x + a4.y) + (a4.z + a4.w);
                const int n = cgp * 256 + cc, dir = n >> 11, ch = n & 2047;
                const float delta = fabsf(MIN_DECAY + (float)ch * ((MAX_DECAY - MIN_DECAY) / 2047.0f));
                const float val = a * expf(-tn * delta);
                if (isctx) KTC[(size_t)(ch * 2 + dir) * 256 + t] = val; else KT[(size_t)(ch * 2 + dir) * LSEQ + t] = (bf16_t)f2bf(val);
            }
        }
        __syncthreads();
    }
    grid.sync();
    if constexpr ((PH >> 2) & 1) {
        const Args& A = kargs_ref(); unsigned char* ws = A.ws; int tid_; asm volatile("v_mbcnt_lo_u32_b32 %0, -1, 0\n\tv_mbcnt_hi_u32_b32 %0, -1, %0" : "=v"(tid_)); tid_ += wave_s * 64; const int tid = tid_, lane = tid & 63, wave = __builtin_amdgcn_readfirstlane(tid >> 6), gw = bx * 8 + wave, NGW = G * 8; (void)lane; (void)gw; (void)NGW;
        pg8::Gemm g{H, WIN, MALL, 8192, 1024}; pg8::StaticOrder So; So.init(MALL, 8192, G, bx);
        pg8::EpiHy E{A.hy_conv_w, A.hy_conv_b, UT, GB, S};
        pg8::gemm_phase<pg8::EpiHy, pg8::StaticOrder, true, true>(lds, g, So, E, tid_);
    }
    grid.sync();
    if constexpr ((PH >> 3) & 1) {
        const Args& A = kargs_ref(); unsigned char* ws = A.ws; int tid_; asm volatile("v_mbcnt_lo_u32_b32 %0, -1, 0\n\tv_mbcnt_hi_u32_b32 %0, -1, %0" : "=v"(tid_)); tid_ += wave_s * 64; const int tid = tid_, lane = tid & 63, wave = __builtin_amdgcn_readfirstlane(tid >> 6), gw = bx * 8 + wave, NGW = G * 8; (void)lane; (void)gw; (void)NGW;
        for (int it = bx * NTHR + tid; it < NSTRIP * 2 * 512; it += G * NTHR) {
            const int c0 = (it & 511) * 4, ri = it >> 9, strip = ri >> 1, which = ri & 1;
            const int row = strip * 64 + (which ? 63 : 0);
            const bool seq_start = (row & (LSEQ - 1)) == 0 || (row >= MLAT && (row & 255) == 0);
            const bool seq_end = ((row + 1) & (LSEQ - 1)) == 0 || (row >= MLAT && ((row + 1) & 255) == 0);
            const float* Sp; const float* Sc; const float* Sn; bool zp = false, zn = false;
            if (which == 0) { zp = seq_start; Sp = S + (size_t)(((zp ? strip : strip - 1) * 4 + 3) * 4) * 2048; Sc = S + (size_t)((strip * 4 + 0) * 4) * 2048; Sn = S + (size_t)((strip * 4 + 1) * 4) * 2048; }
            else { zn = seq_end; Sp = S + (size_t)((strip * 4 + 2) * 4) * 2048; Sc = S + (size_t)((strip * 4 + 3) * 4) * 2048; Sn = S + (size_t)(((zn ? strip : strip + 1) * 4 + 0) * 4) * 2048; }
            f32x4 cv[3];
#pragma unroll
            for (int s = 0; s < 3; ++s) {
                f32x4 pv = *(const f32x4*)(Sp + s * 2048 + c0), cur = *(const f32x4*)(Sc + s * 2048 + c0), nx = *(const f32x4*)(Sn + s * 2048 + c0);
                if (zp) pv = (f32x4){0.f, 0.f, 0.f, 0.f}; if (zn) nx = (f32x4){0.f, 0.f, 0.f, 0.f};
                cv[s] = *(const f32x4*)(A.hy_conv_w + 0 * 6144 + s * 2048 + c0) * pv + *(const f32x4*)(A.hy_conv_w + 1 * 6144 + s * 2048 + c0) * cur
                      + *(const f32x4*)(A.hy_conv_w + 2 * 6144 + s * 2048 + c0) * nx + *(const f32x4*)(A.hy_conv_b + s * 2048 + c0);
            }
            const f32x4 z = *(const f32x4*)(Sc + 3 * 2048 + c0);
            const f32x4 uu = cv[1] * cv[2]; f32x4 g;
#pragma unroll
            for (int j = 0; j < 4; ++j) { g[j] = cv[0][j] * silu_f(z[j]); UT[(size_t)(c0 + j) * MALL + row] = (bf16_t)f2bf(uu[j]); }
            u32x2 gw2; gw2.x = pk2(g[0], g[1]); gw2.y = pk2(g[2], g[3]);
            *(u32x2*)(GB + (size_t)row * 2048 + c0) = gw2;
        }
    }
    grid.sync();
    if constexpr ((PH >> 4) & 1) {
        const Args& A = kargs_ref(); unsigned char* ws = A.ws; int tid_; asm volatile("v_mbcnt_lo_u32_b32 %0, -1, 0\n\tv_mbcnt_hi_u32_b32 %0, -1, %0" : "=v"(tid_)); tid_ += wave_s * 64; const int tid = tid_, lane = tid & 63, wave = __builtin_amdgcn_readfirstlane(tid >> 6), gw = bx * 8 + wave, NGW = G * 8; (void)lane; (void)gw; (void)NGW;
        LAS cf* L = (LAS cf*)lds; LAS float* red = (LAS float*)(lds + 139264); LAS float* Lf = (LAS float*)lds;
        for (int ch = bx; ch < EH; ch += G) {
            int tl = tid_; asm volatile("" : "+v"(tl));
#define tid tl
            cf v[32]; cf* KS = (cf*)(ws + WS_S) + (size_t)bx * 16384 + tid;
            const bf16_t* kf = KT + (size_t)ch * 2 * LSEQ; const bf16_t* kb = kf + LSEQ;
            float asum = 0.f;
#pragma unroll
            for (int m = 0; m < 32; ++m) { const int pos = tid + 512 * m; float kv;
                if (m < 16) kv = bf2f(kf[pos]); else kv = (pos == LSEQ) ? 0.f : bf2f(kb[2 * LSEQ - pos]);
                asum += fabsf(kv); v[m] = cf{kv, 0.f}; }
            const float tot = block_sum(asum, red, tid);
            fft_run<-1>(v, L, tid);
            const float sc = 1.0f / (tot * 16384.0f);
#pragma unroll
            for (int m = 0; m < 32; ++m) KS[512 * m] = cf{v[m].x * sc, v[m].y * sc};
            asm volatile("" : "+v"(tl));
            bf16_t* u0 = UT + (size_t)ch * MALL;
#pragma unroll
            for (int m = 0; m < 32; ++m) { const int pos = tid + 512 * m; v[m] = (m < 16) ? cf{bf2f(u0[pos]), bf2f(u0[LSEQ + pos])} : cf{0.f, 0.f}; }
            fft_run<-1>(v, L, tid);
#pragma unroll
            for (int m = 0; m < 32; ++m) v[m] = cmul(v[m], KS[512 * m]);
            fft_run<1>(v, L, tid);
            asm volatile("" : "+v"(tl));
            const float dsk = A.hy_d[ch];
#pragma unroll
            for (int m = 0; m < 16; ++m) { const int pos = tid + 512 * m; const float ua = bf2f(u0[pos]), ub = bf2f(u0[LSEQ + pos]);
                u0[pos] = (bf16_t)f2bf(v[m].x + dsk * ua); u0[LSEQ + pos] = (bf16_t)f2bf(v[m].y + dsk * ub); }
            asm volatile("" : "+v"(tl));
            const float uc = bf2f(u0[MLAT + tid]); const float kc = KTC[(size_t)ch * 512 + tid];
            Lf[tid] = uc; Lf[512 + tid] = kc;
            const float totc = block_sum((tid == 256) ? 0.f : fabsf(kc), red, tid);
            const int b = tid >> 8, t = tid & 255; float acc = 0.f;
            for (int s = 0; s < 256; ++s) { const float kk = (s <= t) ? Lf[512 + (t - s)] : Lf[768 + (s - t)]; acc += kk * Lf[b * 256 + s]; }
            u0[MLAT + tid] = (bf16_t)f2bf(acc / totc + dsk * uc);
            __syncthreads();
#undef tid
        }
    }
    grid.sync();
    if constexpr ((PH >> 5) & 1) {
        const Args& A = kargs_ref(); unsigned char* ws = A.ws; int tid_; asm volatile("v_mbcnt_lo_u32_b32 %0, -1, 0\n\tv_mbcnt_hi_u32_b32 %0, -1, %0" : "=v"(tid_)); tid_ += wave_s * 64; const int tid = tid_, lane = tid & 63, wave = __builtin_amdgcn_readfirstlane(tid >> 6), gw = bx * 8 + wave, NGW = G * 8; (void)lane; (void)gw; (void)NGW;
        LAS bf16_t* T = (LAS bf16_t*)lds;
        for (int it = bx; it < NSTRIP * 32; it += G) {
            const int r0 = (it >> 5) * 64, c0 = (it & 31) * 64;
            { const int chn = tid >> 3, rc = tid & 7; const u32x4 q = *(const u32x4*)(UT + (size_t)(c0 + chn) * MALL + r0 + 8 * rc);
#pragma unroll
              for (int e = 0; e < 4; ++e) { T[(8 * rc + 2 * e) * 68 + chn] = (bf16_t)(q[e] & 0xffffu); T[(8 * rc + 2 * e + 1) * 68 + chn] = (bf16_t)(q[e] >> 16); } }
            __syncthreads();
            { const int row = tid >> 3, cc = tid & 7; bf16_t* gp = GB + (size_t)(r0 + row) * 2048 + c0 + 8 * cc; const u32x4 gq = *(const u32x4*)gp; u32x4 o;
#pragma unroll
              for (int e = 0; e < 4; ++e) { const float y0 = bf2f(T[row * 68 + 8 * cc + 2 * e]), y1 = bf2f(T[row * 68 + 8 * cc + 2 * e + 1]);
                  o[e] = pk2(y0 * bf2f((bf16_t)(gq[e] & 0xffffu)), y1 * bf2f((bf16_t)(gq[e] >> 16))); }
              *(u32x4*)gp = o; }
            __syncthreads();
        }
    }
    grid.sync();
    if constexpr ((PH >> 6) & 1) {
        const Args& A = kargs_ref(); unsigned char* ws = A.ws; int tid_; asm volatile("v_mbcnt_lo_u32_b32 %0, -1, 0\n\tv_mbcnt_hi_u32_b32 %0, -1, %0" : "=v"(tid_)); tid_ += wave_s * 64; const int tid = tid_, lane = tid & 63, wave = __builtin_amdgcn_readfirstlane(tid >> 6), gw = bx * 8 + wave, NGW = G * 8; (void)lane; (void)gw; (void)NGW;
        pg8::Gemm g{GB, WOUT, MALL, 1024, 2048}; pg8::StaticOrder So; So.init(MALL, 1024, G, bx);
        pg8::EpiRes E{A.x, A.ctx, A.out, X1C, MOD};
        pg8::gemm_phase<pg8::EpiRes, pg8::StaticOrder, true, true>(lds, g, So, E, tid_);
    }
    grid.sync();
    if constexpr ((PH >> 7) & 1) {
        const Args& A = kargs_ref(); unsigned char* ws = A.ws; int tid_; asm volatile("v_mbcnt_lo_u32_b32 %0, -1, 0\n\tv_mbcnt_hi_u32_b32 %0, -1, %0" : "=v"(tid_)); tid_ += wave_s * 64; const int tid = tid_, lane = tid & 63, wave = __builtin_amdgcn_readfirstlane(tid >> 6), gw = bx * 8 + wave, NGW = G * 8; (void)lane; (void)gw; (void)NGW;
        for (int m = gw; m < MALL; m += NGW) { const int src = m < LSEQ ? 0 : (m < MLAT ? 1 : 2);
            const float* xr = m < MLAT ? A.out + (size_t)m * DM : X1C + (size_t)(m - MLAT) * DM;
            norm_row(xr, A.norm_g + DM, MOD + (3 + src) * 3072, H + (size_t)m * DM, lane); }
    }
    grid.sync();
    if constexpr ((PH >> 8) & 1) {
        const Args& A = kargs_ref(); unsigned char* ws = A.ws; int tid_; asm volatile("v_mbcnt_lo_u32_b32 %0, -1, 0\n\tv_mbcnt_hi_u32_b32 %0, -1, %0" : "=v"(tid_)); tid_ += wave_s * 64; const int tid = tid_, lane = tid & 63, wave = __builtin_amdgcn_readfirstlane(tid >> 6), gw = bx * 8 + wave, NGW = G * 8; (void)lane; (void)gw; (void)NGW;
        pg8::Gemm g{H, AWIN, MALL, 5120, 1024}; pg8::StaticOrder So; So.init(MALL, 5120, G, bx);
        pg8::EpiQKV E{A.at_q_g, A.at_k_g, ROPE, Q, KB, VB, ZS, (LAS float*)(lds + LDS_XCH)};
        pg8::gemm_phase<pg8::EpiQKV, pg8::StaticOrder, true, true>(lds, g, So, E, tid_);
    }
    grid.sync();
    if constexpr ((PH >> 9) & 1) {
        const Args& A = kargs_ref(); unsigned char* ws = A.ws; int tid_; asm volatile("v_mbcnt_lo_u32_b32 %0, -1, 0\n\tv_mbcnt_hi_u32_b32 %0, -1, %0" : "=v"(tid_)); tid_ += wave_s * 64; const int tid = tid_, lane = tid & 63, wave = __builtin_amdgcn_readfirstlane(tid >> 6), gw = bx * 8 + wave, NGW = G * 8; (void)lane; (void)gw; (void)NGW;
        for (int un = bx; un < NB * 16 * 32; un += G) {
            const int qb = un & 31, gq = (un >> 5) & 3, kvh = (un >> 7) & 3, b = un >> 9, h = kvh * 4 + gq;
            const size_t qoff = ((size_t)(b * LSEQ + qb * 256)) * 2048 + h * 128, koff = ((size_t)(b * 4 + kvh) * SKV) * 128;
            int t2; asm volatile("v_mbcnt_lo_u32_b32 %0, -1, 0\n\tv_mbcnt_hi_u32_b32 %0, -1, %0" : "=v"(t2)); t2 += wave_s * 64;
            att::attn_dense_body<att::bf16>(Q + qoff, KB + koff, VB + koff, ZS + qoff, SKV, (char*)lds_raw, t2);
        }
    }
    grid.sync();
    if constexpr ((PH >> 10) & 1) {
        const Args& A = kargs_ref(); unsigned char* ws = A.ws; int tid_; asm volatile("v_mbcnt_lo_u32_b32 %0, -1, 0\n\tv_mbcnt_hi_u32_b32 %0, -1, %0" : "=v"(tid_)); tid_ += wave_s * 64; const int tid = tid_, lane = tid & 63, wave = __builtin_amdgcn_readfirstlane(tid >> 6), gw = bx * 8 + wave, NGW = G * 8; (void)lane; (void)gw; (void)NGW;
        pg8::Gemm g{ZS, AWOUT, MLAT, 1024, 2048}; pg8::StaticOrder So; So.init(MLAT, 1024, G, bx);
        pg8::EpiRes E{A.out, A.out, A.out, A.out, MOD + 3 * 3072};
        pg8::gemm_phase<pg8::EpiRes, pg8::StaticOrder, true, true>(lds, g, So, E, tid_);
    }
}

extern "C" void kernel_launch(void* const* d_in, const int* in_sizes, int n_in, void* d_out, int out_size, void* d_ws, size_t ws_size, hipStream_t stream) {
    static int grid = 0;
    if (grid == 0) {
        if (n_in != 24 || out_size != MLAT * DM || ws_size < WS_END) { fprintf(stderr, "kernel_launch: unexpected shapes (n_in %d out %d ws %zu)\n", n_in, out_size, ws_size); grid = -1; return; }
        int dev = 0, cus = 0, per_cu = 0;
        (void)hipGetDevice(&dev); (void)hipDeviceGetAttribute(&cus, hipDeviceAttributeMultiprocessorCount, dev);
        if (hipFuncSetAttribute((const void*)mk_fwd, hipFuncAttributeMaxDynamicSharedMemorySize, LDS_BYTES) != hipSuccess) { fprintf(stderr, "kernel_launch: hipFuncSetAttribute failed\n"); grid = -1; return; }
        if (hipOccupancyMaxActiveBlocksPerMultiprocessor(&per_cu, (const void*)mk_fwd, NTHR, LDS_BYTES) != hipSuccess || per_cu < 1) { fprintf(stderr, "kernel_launch: occupancy query says %d\n", per_cu); per_cu = 1; }
        (void)hipGetLastError();
        grid = cus;
    }
    if (grid < 0) return;
    Args a{};
    const float** p = (const float**)&a;
    for (int i = 0; i < 24; ++i) p[i] = (const float*)d_in[i];
    a.out = (float*)d_out; a.ws = (unsigned char*)d_ws;
    void* args[] = {&a};
    hipError_t e = hipLaunchCooperativeKernel((const void*)mk_fwd, dim3(grid), dim3(NTHR), args, LDS_BYTES, stream);
    if (e != hipSuccess) fprintf(stderr, "cooperative launch failed: %s (grid %d)\n", hipGetErrorString(e), grid);
}
```

```cpp
#include <hip/hip_runtime.h>
#include <hip/hip_cooperative_groups.h>
#include <cstdio>
#include <cstdint>
namespace cg = cooperative_groups;

#define LAS __attribute__((address_space(3)))
typedef unsigned short bf16_t;
typedef float f32x4 __attribute__((ext_vector_type(4)));
typedef unsigned u32x4 __attribute__((ext_vector_type(4)));
typedef unsigned u32x2 __attribute__((ext_vector_type(2)));

constexpr int DM = 1024, LSEQ = 8192, NB = 2, CTX = 256, EH = 2048;
constexpr int MLAT = NB * LSEQ, MALL = MLAT + NB * CTX;
constexpr int SKV = LSEQ + CTX;
constexpr int NSTRIP = MALL / 64;
constexpr float MAX_DECAY = -15.350567286626973f, MIN_DECAY = -3.0701134573253945f;
constexpr float EPSN = 1e-6f;
constexpr int NTHR = 512;

constexpr size_t MiB = 1u << 20;
constexpr size_t WS_CTL = 0, CTL_ZERO_BYTES = 16384;
constexpr size_t WS_MOD = 1 * MiB;
constexpr size_t WS_H3 = 2 * MiB;
constexpr size_t WS_H3C = 4 * MiB;
constexpr size_t WS_ROPE = 5 * MiB;
constexpr size_t WS_KTC = 6 * MiB;
constexpr size_t WS_X1C = 10 * MiB;
constexpr size_t WS_WIN = 12 * MiB;
constexpr size_t WS_WOUT = 28 * MiB;
constexpr size_t WS_AWIN = 32 * MiB;
constexpr size_t WS_AWOUT = 42 * MiB;
constexpr size_t WS_H = 46 * MiB;
constexpr size_t WS_S = 79 * MiB;
constexpr size_t WS_UT = 112 * MiB;
constexpr size_t WS_G = 178 * MiB;
constexpr size_t WS_Q = 112 * MiB;
constexpr size_t WS_ZS = 176 * MiB;
constexpr size_t WS_KB = 79 * MiB;
constexpr size_t WS_VB = WS_KB + (size_t)NB * 4 * SKV * 128 * 2;
constexpr size_t WS_END = 244 * MiB;
static_assert(WS_VB + (size_t)NB * 4 * SKV * 128 * 2 <= WS_Q, "kv map");
static_assert(WS_ZS + (size_t)MLAT * 2048 * 2 <= WS_END, "zs map");

constexpr int LDS_BYTES = 147456;
constexpr int LDS_XCH = 131072;
constexpr int LDS_MISC = LDS_BYTES - 64;

__device__ __forceinline__ unsigned f2bf(float f) { unsigned u = __builtin_bit_cast(unsigned, f); return (u + 0x7fffu + ((u >> 16) & 1u)) >> 16; }
__device__ __forceinline__ float bf2f(unsigned short h) { return __builtin_bit_cast(float, (unsigned)h << 16); }
__device__ __forceinline__ unsigned pk2(float lo, float hi) { return f2bf(lo) | (f2bf(hi) << 16); }
__device__ __forceinline__ float silu_f(float z) { return z / (1.f + __expf(-z)); }
__device__ __forceinline__ float wave_sum(float v) {
#pragma unroll
    for (int o = 1; o < 64; o <<= 1) v += __shfl_xor(v, o);
    return v;
}
namespace pg8 {
#define PG8_LAS __attribute__((address_space(3)))
typedef short bf16x8 __attribute__((ext_vector_type(8)));
constexpr int BM = 256, BK = 64, HALF = 128, HTB = HALF * BK * 2  , STAGE_BYTES = 8 * HTB, NXCD = 8, WGM = 8;

__host__ __device__ __forceinline__ int lds_byte(int r, int c) { const int st = (r >> 4) * 2 + (c >> 5), rr = r & 15, cc = c & 31, ob = rr * 64 + cc * 2; return st * 1024 + (ob ^ (((ob >> 9) & 1) << 5)); }
__host__ __device__ __forceinline__ void stage_rc(int b, int& R, int& C) { const int st = b / 1024, sb = b % 1024, swz = sb ^ (((sb >> 9) & 1) << 5); R = (st >> 1) * 16 + swz / 64; C = (st & 1) * 32 + (swz % 64) / 2; }
__host__ __device__ __forceinline__ int perm32(int rho) { const int n = rho >> 4, i = rho & 15; return 8 * (i >> 2) + 4 * n + (i & 3); }

struct Unit { int pm, pn; };
struct Gemm { const bf16_t* A; const bf16_t* Bt; int M, N, K; };
struct StaticOrder {
    int nM, nN, nwg, G, c;
    __host__ __device__ void init(int M, int N, int G_, int c_) { nM = M / BM; nN = N / BM; nwg = nM * nN; G = G_; c = c_; }
    __host__ __device__ bool next(int i, Unit& u) const {
        const long L = (long)i * G + c; if (L >= nwg) return false;
        int wgid = (int)L; { const int q = nwg / NXCD, r = nwg % NXCD, xcd = wgid % NXCD, off = wgid / NXCD; wgid = (xcd < r ? xcd * (q + 1) : r * (q + 1) + (xcd - r) * q) + off; }
        const int nig = WGM * nN, gid = wgid / nig, fm = gid * WGM, gsz = (nM - fm) < WGM ? (nM - fm) : WGM;
        u.pm = fm + ((wgid % nig) % gsz); u.pn = (wgid % nig) / gsz; return true;
    }
    __device__ __forceinline__ void a_ready(const Unit&) const {}
    __device__ __forceinline__ void done(const Unit&) const {}
};
__device__ __forceinline__ unsigned cvt_pk_bf16(float lo, float hi) { unsigned r; asm volatile("v_cvt_pk_bf16_f32 %0, %1, %2" : "=v"(r) : "v"(lo), "v"(hi)); return r; }
typedef float f32x2 __attribute__((ext_vector_type(2)));
struct EpiHy {
    static constexpr bool PERM = true, AFTER_DRAIN = false;
    const float* cw; const float* cb; bf16_t* UT; bf16_t* G; float* S;
    __device__ __forceinline__ void operator()(const f32x4 (&acc)[2][2][4][2], const Unit& u, int wr, int wc, int fr, int fq) const {
        asm volatile("" : "+v"(fr), "+v"(fq));
        const int lane = fq * 16 + fr;
        const int c0 = u.pn * 64 + 16 * wc + 4 * fq;
        const int srcP = (lane & 48) | ((fr + 15) & 15), srcN = (lane & 48) | ((fr + 1) & 15);
        f32x4 w[3][3], bb[3];
#pragma unroll
        for (int s = 0; s < 3; ++s) { bb[s] = *(const f32x4*)(cb + s * 2048 + c0);
#pragma unroll
            for (int t = 0; t < 3; ++t) w[s][t] = *(const f32x4*)(cw + t * 6144 + s * 2048 + c0); }
#pragma unroll
        for (int ai = 0; ai < 2; ++ai) {
            const int strip = u.pm * 4 + ai * 2 + wr;
#pragma unroll
            for (int m = 0; m < 4; ++m) {
                f32x4 cv[3];
#pragma unroll
                for (int s = 0; s < 3; ++s) {
                    const f32x4 cur = acc[ai][s >> 1][m][s & 1];
                    const f32x4 up = acc[ai][s >> 1][m > 0 ? m - 1 : 0][s & 1];
                    const f32x4 dn = acc[ai][s >> 1][m < 3 ? m + 1 : 3][s & 1];
                    f32x4 pv, nx;
#pragma unroll
                    for (int j = 0; j < 4; ++j) { const float sp = (fr == 15) ? up[j] : cur[j], sn = (fr == 0) ? dn[j] : cur[j]; pv[j] = __shfl(sp, srcP); nx[j] = __shfl(sn, srcN); }
                    cv[s] = w[s][0] * pv + w[s][1] * cur + w[s][2] * nx + bb[s];
                }
                const f32x4 z = acc[ai][1][m][1];
                const bool interior = !((m == 0 && fr == 0) || (m == 3 && fr == 15));
                if (interior) {
                    const int row = strip * 64 + 16 * m + fr;
                    const f32x4 uu = cv[1] * cv[2];
                    f32x4 g;
#pragma unroll
                    for (int j = 0; j < 4; ++j) { g[j] = cv[0][j] * silu_f(z[j]); UT[(size_t)(c0 + j) * MALL + row] = (bf16_t)f2bf(uu[j]); }
                    u32x2 gw; gw.x = pk2(g[0], g[1]); gw.y = pk2(g[2], g[3]);
                    *(u32x2*)(G + (size_t)row * 2048 + c0) = gw;
                }
                __builtin_amdgcn_sched_barrier(0);
            }
            if (fr < 2) {
#pragma unroll
                for (int s = 0; s < 4; ++s) *(f32x4*)(S + ((size_t)((strip * 4 + fr) * 4 + s)) * 2048 + c0) = acc[ai][s >> 1][0][s & 1];
            }
            if (fr >= 14) {
#pragma unroll
                for (int s = 0; s < 4; ++s) *(f32x4*)(S + ((size_t)((strip * 4 + fr - 12) * 4 + s)) * 2048 + c0) = acc[ai][s >> 1][3][s & 1];
            }
        }
    }
};
struct EpiRes {
    static constexpr bool PERM = true, AFTER_DRAIN = false;
    const float* xlat; const float* xctx; float* olat; float* octx; const float* mod;
    __device__ __forceinline__ void operator()(const f32x4 (&acc)[2][2][4][2], const Unit& u, int wr, int wc, int fr, int fq) const {
        asm volatile("" : "+v"(fr), "+v"(fq));
        const int col0 = u.pn * 256 + wc * 32 + 8 * fq;
#pragma unroll
        for (int ai = 0; ai < 2; ++ai)
#pragma unroll
            for (int m = 0; m < 4; ++m) {
                const int row = u.pm * 256 + ai * 128 + wr * 64 + m * 16 + fr;
                const int src = row < LSEQ ? 0 : (row < MLAT ? 1 : 2);
                const float* xi; float* od;
                if (row < MLAT) { xi = xlat + (size_t)row * DM; od = olat + (size_t)row * DM; } else { xi = xctx + (size_t)(row - MLAT) * DM; od = octx + (size_t)(row - MLAT) * DM; }
                const float* gt = mod + src * 3072 + 2048;
#pragma unroll
                for (int bj = 0; bj < 2; ++bj) { const int col = col0 + bj * 128;
                    const f32x4 g0 = *(const f32x4*)(gt + col), g1 = *(const f32x4*)(gt + col + 4), x0 = *(const f32x4*)(xi + col), x1 = *(const f32x4*)(xi + col + 4);
                    *(f32x4*)(od + col) = x0 + g0 * acc[ai][bj][m][0]; *(f32x4*)(od + col + 4) = x1 + g1 * acc[ai][bj][m][1]; }
            }
    }
};
struct EpiQKV {
    static constexpr bool PERM = true, AFTER_DRAIN = false;
    const float* qg; const float* kg; const float* rope; bf16_t* Q; bf16_t* KB; bf16_t* VB; bf16_t* ZS; PG8_LAS float* xl;
    __device__ __forceinline__ void operator()(const f32x4 (&acc)[2][2][4][2], const Unit& u, int wr, int wc, int fr, int fq) const {
        asm volatile("" : "+v"(fr), "+v"(fq));
        const int pn = u.pn;
        if (pn < 10) {
            const bool isq = pn < 8;
#pragma unroll
            for (int ai = 0; ai < 2; ++ai)
#pragma unroll
                for (int m = 0; m < 4; ++m)
#pragma unroll
                    for (int bj = 0; bj < 2; ++bj) { const f32x4 a = acc[ai][bj][m][0], b = acc[ai][bj][m][1];
                        float s = (a[0] * a[0] + a[1] * a[1]) + (a[2] * a[2] + a[3] * a[3]) + (b[0] * b[0] + b[1] * b[1]) + (b[2] * b[2] + b[3] * b[3]);
                        s += __shfl_xor(s, 16); s += __shfl_xor(s, 32);
                        if (fq == 0) xl[((ai * 128 + wr * 64 + m * 16 + fr) * 2 + bj) * 4 + wc] = s; }
            asm volatile("s_waitcnt lgkmcnt(0)" ::: "memory"); __builtin_amdgcn_s_barrier(); asm volatile("" ::: "memory");
            const float* gg = isq ? qg : kg; const int d0 = 2 * (4 * wc + fq);
            float gv[2][4];
#pragma unroll
            for (int n = 0; n < 2; ++n)
#pragma unroll
                for (int j = 0; j < 4; ++j) gv[n][j] = gg[32 * (2 * n + (j >> 1)) + d0 + (j & 1)];
#pragma unroll
            for (int ai = 0; ai < 2; ++ai)
#pragma unroll
                for (int m = 0; m < 4; ++m) {
                    const int rl = ai * 128 + wr * 64 + m * 16 + fr, row = u.pm * 256 + rl;
                    const bool lat = row < MLAT; const int t = row & (LSEQ - 1);
                    const f32x4 rr = *(const f32x4*)(rope + ((t >> 6) * 32 + d0) * 2);
                    const f32x4 rc = *(const f32x4*)(rope + ((t & 63) * 32 + d0) * 2);
                    int bb_, ss_; if (lat) { bb_ = row >> 13; ss_ = t; } else { bb_ = (row - MLAT) >> 8; ss_ = LSEQ + ((row - MLAT) & 255); }
#pragma unroll
                    for (int bj = 0; bj < 2; ++bj) {
                        const f32x4 p4 = *(const PG8_LAS f32x4*)(xl + (rl * 2 + bj) * 4);
                        const float rinv = rsqrtf(((p4[0] + p4[1]) + (p4[2] + p4[3])) * (1.f / 128.f) + EPSN);
                        float y[2][4], o[2][4];
#pragma unroll
                        for (int n = 0; n < 2; ++n)
#pragma unroll
                            for (int j = 0; j < 4; ++j) y[n][j] = acc[ai][bj][m][n][j] * rinv * gv[n][j];
                        if (lat) {
#pragma unroll
                            for (int e = 0; e < 2; ++e) {
                                o[0][e] = y[0][e] * rr[2 * e] - y[0][2 + e] * rr[2 * e + 1]; o[0][2 + e] = y[0][e] * rr[2 * e + 1] + y[0][2 + e] * rr[2 * e];
                                o[1][e] = y[1][e] * rc[2 * e] - y[1][2 + e] * rc[2 * e + 1]; o[1][2 + e] = y[1][e] * rc[2 * e + 1] + y[1][2 + e] * rc[2 * e]; }
                        } else {
#pragma unroll
                            for (int n = 0; n < 2; ++n)
#pragma unroll
                                for (int j = 0; j < 4; ++j) o[n][j] = y[n][j];
                        }
                        u32x4 wv; wv.x = pk2(o[0][0], o[0][1]); wv.y = pk2(o[0][2], o[0][3]); wv.z = pk2(o[1][0], o[1][1]); wv.w = pk2(o[1][2], o[1][3]);
                        if (isq) { if (lat) *(u32x4*)(Q + (size_t)row * 2048 + (2 * pn + bj) * 128 + 32 * wc + 8 * fq) = wv; }
                        else { const int kvh = 2 * (pn - 8) + bj; *(u32x4*)(KB + ((size_t)(bb_ * 4 + kvh) * SKV + ss_) * 128 + 32 * wc + 8 * fq) = wv; }
                        __builtin_amdgcn_sched_barrier(0);
                    }
                }
        } else {
#pragma unroll
            for (int ai = 0; ai < 2; ++ai)
#pragma unroll
                for (int m = 0; m < 4; ++m) {
                    const int row = u.pm * 256 + ai * 128 + wr * 64 + m * 16 + fr;
                    const bool lat = row < MLAT; const int t = row & (LSEQ - 1);
                    int bb_, ss_; if (lat) { bb_ = row >> 13; ss_ = t; } else { bb_ = (row - MLAT) >> 8; ss_ = LSEQ + ((row - MLAT) & 255); }
#pragma unroll
                    for (int bj = 0; bj < 2; ++bj) {
                        f32x4 a = acc[ai][bj][m][0], b = acc[ai][bj][m][1];
                        if (pn < 12) {
                            u32x4 wv; wv.x = pk2(a[0], a[1]); wv.y = pk2(a[2], a[3]); wv.z = pk2(b[0], b[1]); wv.w = pk2(b[2], b[3]);
                            const int kvh = 2 * (pn - 10) + bj; *(u32x4*)(VB + ((size_t)(bb_ * 4 + kvh) * SKV + ss_) * 128 + 32 * wc + 8 * fq) = wv;
                        } else if (lat) {
#pragma unroll
                            for (int j = 0; j < 4; ++j) { a[j] = silu_f(a[j]); b[j] = silu_f(b[j]); }
                            u32x4 wv; wv.x = pk2(a[0], a[1]); wv.y = pk2(a[2], a[3]); wv.z = pk2(b[0], b[1]); wv.w = pk2(b[2], b[3]);
                            *(u32x4*)(ZS + (size_t)row * 2048 + (pn - 12) * 256 + bj * 128 + 32 * wc + 8 * fq) = wv;
                        }
                    }
                }
        }
    }
};
template <class Epi, class Sched, bool ALIGN_EPI = false, bool SP2 = false>
__device__ __forceinline__ void gemm_phase(PG8_LAS unsigned char* lds, const Gemm g, const Sched& S, const Epi& E, int tid_) {
    asm volatile("" : "+v"(tid_));
    const int tid = tid_, wid = __builtin_amdgcn_readfirstlane(tid >> 6), lane = tid & 63, wr = wid >> 2, wc = wid & 3, fr = lane & 15, fq = lane >> 4;
    const int K = g.K, nt = K / BK;
    unsigned voffA[2], voffB[2];
#pragma unroll
    for (int i = 0; i < 2; ++i) { int R, C; stage_rc(tid * 16 + i * 8192, R, C); const int Rb = Epi::PERM ? ((R & ~31) + perm32(R & 31)) : R;
        voffA[i] = (unsigned)(R * K + C) * 2u; voffB[i] = (unsigned)(Rb * K + C) * 2u; }
    const size_t kstep = (size_t)(BK * 2);
    const size_t hstep = (size_t)HALF * K * 2;
    const size_t tstep = 2 * hstep;
    const unsigned ldsw = (unsigned)wid * 1024u;
    const int aoff = lds_byte(wr * 64 + fr, fq * 8), boff = lds_byte(wc * 32 + fr, fq * 8);
#define PG8_SA(b, h) (((b) * 2 + (h)) * HTB)
#define PG8_SB(b, h) ((4 + (b) * 2 + (h)) * HTB)
#define PG8_STAGE(bufoff, gbase, voff) do { _Pragma("unroll") for (int _i = 0; _i < 2; ++_i) \
        __builtin_amdgcn_global_load_lds((const unsigned*)((const char*)(gbase) + (voff)[_i]), (PG8_LAS unsigned*)(lds + (bufoff) + ldsw + _i * 8192), 16, 0, 0); } while (0)
#define PG8_LDA(dst, b, h) do { _Pragma("unroll") for (int m = 0; m < 4; ++m) _Pragma("unroll") for (int k = 0; k < 2; ++k) dst[m][k] = *(const PG8_LAS bf16x8*)(lds + PG8_SA(b, h) + aoff + m * 2048 + k * 1024); } while (0)
#define PG8_LDB(dst, b, h) do { _Pragma("unroll") for (int n = 0; n < 2; ++n) _Pragma("unroll") for (int k = 0; k < 2; ++k) dst[n][k] = *(const PG8_LAS bf16x8*)(lds + PG8_SB(b, h) + boff + n * 2048 + k * 1024); } while (0)
#define PG8_MMA(ai, bj, At, Bt) do { __builtin_amdgcn_s_setprio(1); _Pragma("unroll") for (int m = 0; m < 4; ++m) _Pragma("unroll") for (int n = 0; n < 2; ++n) _Pragma("unroll") for (int k = 0; k < 2; ++k) \
        acc[ai][bj][m][n] = __builtin_amdgcn_mfma_f32_16x16x32_bf16(Bt[n][k], At[m][k], acc[ai][bj][m][n], 0, 0, 0); __builtin_amdgcn_s_setprio(0); } while (0)
#define PG8_WAIT_V(n) asm volatile("s_waitcnt vmcnt(" #n ")" ::: "memory")
#define PG8_WAIT_L(n) asm volatile("s_waitcnt lgkmcnt(" #n ")" ::: "memory")
#define PG8_BAR __builtin_amdgcn_s_barrier()
#define PG8_SCHED __builtin_amdgcn_sched_barrier(0)
    Unit cur, nxt; int ui = 0;
    if (!S.next(0, cur)) return;
    f32x4 acc[2][2][4][2];
#pragma unroll
    for (int a = 0; a < 2; ++a)
#pragma unroll
        for (int b = 0; b < 2; ++b)
#pragma unroll
            for (int m = 0; m < 4; ++m)
#pragma unroll
                for (int n = 0; n < 2; ++n) acc[a][b][m][n] = (f32x4){0.f, 0.f, 0.f, 0.f};
    bf16x8 At[4][2], B0[2][2], B1[2][2];
    const char* cA = (const char*)g.A + (size_t)cur.pm * tstep; const char* cB = (const char*)g.Bt + (size_t)cur.pn * tstep;
    S.a_ready(cur);
    if constexpr (SP2) {
        PG8_STAGE(PG8_SB(0, 0), cB, voffB); PG8_STAGE(PG8_SB(0, 1), cB + hstep, voffB); PG8_STAGE(PG8_SA(0, 0), cA, voffA); PG8_STAGE(PG8_SA(0, 1), cA + hstep, voffA);
        if (wr == 1) PG8_BAR;
        PG8_WAIT_V(2); PG8_BAR;
        PG8_STAGE(PG8_SB(1, 0), cB + kstep, voffB); PG8_STAGE(PG8_SA(1, 0), cA + kstep, voffA); PG8_STAGE(PG8_SB(1, 1), cB + hstep + kstep, voffB);
        PG8_WAIT_V(6); PG8_BAR;
    } else {
        PG8_STAGE(PG8_SB(0, 0), cB, voffB); PG8_STAGE(PG8_SA(0, 0), cA, voffA); PG8_STAGE(PG8_SB(0, 1), cB + hstep, voffB); PG8_STAGE(PG8_SA(0, 1), cA + hstep, voffA);
        if (wr == 1) PG8_BAR;
        PG8_WAIT_V(4); PG8_BAR;
        PG8_STAGE(PG8_SB(1, 0), cB + kstep, voffB); PG8_STAGE(PG8_SA(1, 0), cA + kstep, voffA); PG8_STAGE(PG8_SB(1, 1), cB + hstep + kstep, voffB);
        PG8_WAIT_V(6); PG8_BAR;
    }
    for (;;) {
        const bool has_next = S.next(ui + 1, nxt);
        const char* nA = has_next ? (const char*)g.A + (size_t)nxt.pm * tstep : cA; const char* nB = has_next ? (const char*)g.Bt + (size_t)nxt.pn * tstep : cB;
        for (int t = 0; t < nt; t += 2) {
            const bool last = (t == nt - 2);
            const char* a1 = cA + (size_t)(t + 1) * kstep;
            const char* a2 = last ? nA : cA + (size_t)(t + 2) * kstep; const char* b2 = last ? nB : cB + (size_t)(t + 2) * kstep;
            const char* a3 = a2 + kstep; const char* b3 = b2 + kstep;
            if (last && has_next) S.a_ready(nxt);
            if constexpr (SP2) {
            PG8_LDB(B0, 0, 0); PG8_LDB(B1, 0, 1); PG8_SCHED; PG8_LDA(At, 0, 0); PG8_STAGE(PG8_SA(1, 1), a1 + hstep, voffA);
            PG8_WAIT_V(8); PG8_WAIT_L(0); PG8_BAR; PG8_MMA(0, 0, At, B0); PG8_MMA(0, 1, At, B1); PG8_BAR; PG8_SCHED;
            PG8_LDA(At, 0, 1); PG8_STAGE(PG8_SB(0, 0), b2, voffB); PG8_STAGE(PG8_SB(0, 1), b2 + hstep, voffB); PG8_STAGE(PG8_SA(0, 0), a2, voffA);
            PG8_WAIT_V(8); PG8_WAIT_L(0); PG8_BAR; PG8_MMA(1, 0, At, B0); PG8_MMA(1, 1, At, B1); PG8_BAR; PG8_SCHED;
            PG8_LDB(B0, 1, 0); PG8_LDB(B1, 1, 1); PG8_SCHED; PG8_LDA(At, 1, 0); PG8_STAGE(PG8_SA(0, 1), a2 + hstep, voffA);
            PG8_WAIT_V(8); PG8_WAIT_L(0); PG8_BAR; PG8_MMA(0, 0, At, B0); PG8_MMA(0, 1, At, B1); PG8_BAR; PG8_SCHED;
            PG8_LDA(At, 1, 1); PG8_STAGE(PG8_SB(1, 0), b3, voffB); PG8_STAGE(PG8_SB(1, 1), b3 + hstep, voffB); PG8_STAGE(PG8_SA(1, 0), a3, voffA);
            PG8_WAIT_V(8); PG8_WAIT_L(0); PG8_BAR; PG8_MMA(1, 0, At, B0); PG8_MMA(1, 1, At, B1); PG8_BAR; PG8_SCHED;
            } else {
            PG8_LDB(B0, 0, 0); PG8_SCHED; PG8_LDA(At, 0, 0); PG8_STAGE(PG8_SA(1, 1), a1 + hstep, voffA);
            PG8_WAIT_L(8); PG8_BAR; PG8_WAIT_L(0); PG8_MMA(0, 0, At, B0); PG8_BAR; PG8_SCHED;
            PG8_LDB(B1, 0, 1); PG8_STAGE(PG8_SB(0, 0), b2, voffB);
            PG8_BAR; PG8_WAIT_L(0); PG8_MMA(0, 1, At, B1); PG8_BAR;
            PG8_LDA(At, 0, 1); PG8_STAGE(PG8_SA(0, 0), a2, voffA);
            PG8_BAR; PG8_WAIT_L(0); PG8_MMA(1, 0, At, B0); PG8_BAR; PG8_SCHED;
            PG8_STAGE(PG8_SB(0, 1), b2 + hstep, voffB);
            PG8_WAIT_V(6); PG8_BAR; PG8_MMA(1, 1, At, B1); PG8_BAR;
            PG8_LDB(B0, 1, 0); PG8_SCHED; PG8_LDA(At, 1, 0); PG8_STAGE(PG8_SA(0, 1), a2 + hstep, voffA);
            PG8_WAIT_L(8); PG8_BAR; PG8_WAIT_L(0); PG8_MMA(0, 0, At, B0); PG8_BAR; PG8_SCHED;
            PG8_LDB(B1, 1, 1); PG8_STAGE(PG8_SB(1, 0), b3, voffB);
            PG8_BAR; PG8_WAIT_L(0); PG8_MMA(0, 1, At, B1); PG8_BAR;
            PG8_LDA(At, 1, 1); PG8_STAGE(PG8_SA(1, 0), a3, voffA);
            PG8_BAR; PG8_WAIT_L(0); PG8_MMA(1, 0, At, B0); PG8_BAR; PG8_SCHED;
            PG8_STAGE(PG8_SB(1, 1), b3 + hstep, voffB);
            PG8_WAIT_V(6); PG8_BAR; PG8_MMA(1, 1, At, B1); PG8_BAR;
            }
        }
        if constexpr (ALIGN_EPI) { if (wr == 0) PG8_BAR; }
        if constexpr (!Epi::AFTER_DRAIN) { E(acc, cur, wr, wc, fr, fq); S.done(cur); }
        if (!has_next) break;
#pragma unroll
        for (int a = 0; a < 2; ++a)
#pragma unroll
            for (int b = 0; b < 2; ++b)
#pragma unroll
                for (int m = 0; m < 4; ++m)
#pragma unroll
                    for (int n = 0; n < 2; ++n) acc[a][b][m][n] = (f32x4){0.f, 0.f, 0.f, 0.f};
        cur = nxt; cA = nA; cB = nB; ++ui;
        if constexpr (ALIGN_EPI) { if (wr == 1) PG8_BAR; }
    }
    PG8_WAIT_V(0);
    if constexpr (!ALIGN_EPI) { if (wr == 0) PG8_BAR; }
    PG8_BAR;
    if constexpr (Epi::AFTER_DRAIN) { E.fused(acc, cur, wr, wc, fr, fq, lds, wid, lane); S.done(cur); }
#undef PG8_SA
#undef PG8_SB
#undef PG8_STAGE
#undef PG8_LDA
#undef PG8_LDB
#undef PG8_MMA
#undef PG8_WAIT_V
#undef PG8_WAIT_L
#undef PG8_BAR
#undef PG8_SCHED
}
}
namespace att {
typedef unsigned short bf16;
constexpr int   D = 128, NW = 8, QBLK = 32, KVBLK = 64;
constexpr float SCALE = 0.088388347648318440f;
constexpr float THR = 8.f;
constexpr int SDEPTH = 2;
constexpr int LDQ = 2048, LDK = 128, LDO = 2048;
constexpr size_t SHM_V = KVBLK * D * 2, SHM_K = KVBLK * D * 2, SHM_ATTN = 2 * SHM_V + 2 * SHM_K + NW * 64 * 4;
using bf16x8 = __attribute__((ext_vector_type(8))) short;
using s16x4  = __attribute__((ext_vector_type(4))) short;
using f32x16 = __attribute__((ext_vector_type(16))) float;
using f32x8  = __attribute__((ext_vector_type(8))) float;
using u32x4  = __attribute__((ext_vector_type(4))) unsigned;
#define KSWZ(row, colB) ((row) * 256 + ((colB) ^ (((row) & 7) << 4)))
#define SBAR() __builtin_amdgcn_sched_barrier(0)
__device__ __forceinline__ int crow(int r, int hi) { return (r & 3) + 8 * (r >> 2) + 4 * hi; }
__device__ __forceinline__ unsigned cvtpk(float lo, float hi) {
  unsigned r; asm volatile("v_cvt_pk_bf16_f32 %0, %1, %2" : "=v"(r) : "v"(lo), "v"(hi)); return r;
}
template <typename TIn> struct Stage;
template <> struct Stage<bf16>  { using T = bf16x8;
  __device__ static __forceinline__ T ld8(const bf16* p) { return *reinterpret_cast<const bf16x8*>(p); }
  __device__ static __forceinline__ bf16x8 tobf(T x) { return x; } };
__device__ __forceinline__ void partialSM(f32x16& p0, f32x16& p1, float& m_reg, float& mn, float& alpha) {
  constexpr float C = SCALE * 1.4426950408889634f;
  float pmax = p0[0]; for (int r = 1; r < 16; ++r) pmax = fmaxf(pmax, p0[r]); for (int r = 0; r < 16; ++r) pmax = fmaxf(pmax, p1[r]);
  { auto rr = __builtin_amdgcn_permlane32_swap(__float_as_uint(pmax), __float_as_uint(pmax), false, false);
    pmax = fmaxf(__uint_as_float(rr[0]), __uint_as_float(rr[1])); }
  if (__builtin_expect(__all(pmax - m_reg <= THR / SCALE), 1)) { mn = m_reg; alpha = 1.f; }
  else { mn = fmaxf(m_reg, pmax); alpha = __builtin_amdgcn_exp2f((m_reg - mn) * C); m_reg = mn; }
  float mnC = -mn * C;
  for (int r = 0; r < 16; ++r) p0[r] = fmaf(p0[r], C, mnC); for (int r = 0; r < 16; ++r) p1[r] = fmaf(p1[r], C, mnC);
  for (int r = 0; r < 16; ++r) p0[r] = __builtin_amdgcn_exp2f(p0[r]);
}
__device__ __forceinline__ void finishSM(f32x16& p0, f32x16& p1, float alpha, float& l_reg, bf16x8& pa0, bf16x8& pa1, bf16x8& pa2, bf16x8& pa3) {
  for (int r = 0; r < 16; ++r) p1[r] = __builtin_amdgcn_exp2f(p1[r]);
  float ps = 0; for (int r = 0; r < 16; ++r) ps += p0[r]; for (int r = 0; r < 16; ++r) ps += p1[r];
  { auto rr = __builtin_amdgcn_permlane32_swap(__float_as_uint(ps), __float_as_uint(ps), false, false);
    ps = __uint_as_float(rr[0]) + __uint_as_float(rr[1]); }
  l_reg = l_reg * alpha + ps;
#define PK4(P, BASE, OUT) do { unsigned a0 = cvtpk(P[BASE + 0], P[BASE + 1]), a1 = cvtpk(P[BASE + 2], P[BASE + 3]);   \
    unsigned b0 = cvtpk(P[BASE + 4], P[BASE + 5]), b1 = cvtpk(P[BASE + 6], P[BASE + 7]);                              \
    auto r0 = __builtin_amdgcn_permlane32_swap(a0, b0, false, false); auto r1 = __builtin_amdgcn_permlane32_swap(a1, b1, false, false); \
    u32x4 w = {r0[0], r1[0], r0[1], r1[1]}; OUT = *reinterpret_cast<bf16x8*>(&w); } while (0)
  PK4(p0, 0, pa0); PK4(p0, 8, pa1); PK4(p1, 0, pa2); PK4(p1, 8, pa3);
#undef PK4
}
__device__ __forceinline__ void qkt(f32x16& p0, f32x16& p1, const bf16* Ks, const bf16x8* qr, int r32, int hi) {
  p0 = f32x16{}; p1 = f32x16{};
  for (int d0 = 0; d0 < 8; ++d0) { int cb = (d0 * 16 + hi * 8) * 2;
    bf16x8 b0 = *reinterpret_cast<const bf16x8*>((const char*)Ks + KSWZ(r32, cb));
    bf16x8 b1 = *reinterpret_cast<const bf16x8*>((const char*)Ks + KSWZ(32 + r32, cb));
    p0 = __builtin_amdgcn_mfma_f32_32x32x16_bf16(b0, qr[d0], p0, 0, 0, 0);
    p1 = __builtin_amdgcn_mfma_f32_32x32x16_bf16(b1, qr[d0], p1, 0, 0, 0); }
}
__device__ __forceinline__ int v_st(int k, int c) { const int kk = (k & ~0xC) | ((k & 4) << 1) | ((k & 8) >> 1); return ((kk >> 3) * 4 + (c >> 5)) * 512 + ((kk & 7) * 32 + (c & 31)) * 2; }
__device__ __forceinline__ int v_rd_base(int lane) { return ((lane & 3) << 3) | (((lane >> 2) & 3) << 6) | (((lane >> 4) & 1) << 5) | (((lane >> 5) & 1) << 8); }
constexpr int v_rd_off(int d0, int ks, int half) { return d0 * 512 + ks * 4096 + half * 2048; }
template <int OFF> __device__ __forceinline__ s16x4 tr_read(int vb) {
  s16x4 r; asm volatile("ds_read_b64_tr_b16 %0, %1 offset:%2" : "=&v"(r) : "v"(vb), "i"(OFF) : "memory"); return r;
}
template <int D0> __device__ __forceinline__ void pv_one(f32x16& od, int vb, bf16x8 pa0, bf16x8 pa1, bf16x8 pa2, bf16x8 pa3) {
  const s16x4 l0 = tr_read<v_rd_off(D0, 0, 0)>(vb), h0 = tr_read<v_rd_off(D0, 0, 1)>(vb), l1 = tr_read<v_rd_off(D0, 1, 0)>(vb), h1 = tr_read<v_rd_off(D0, 1, 1)>(vb);
  const s16x4 l2 = tr_read<v_rd_off(D0, 2, 0)>(vb), h2 = tr_read<v_rd_off(D0, 2, 1)>(vb), l3 = tr_read<v_rd_off(D0, 3, 0)>(vb), h3 = tr_read<v_rd_off(D0, 3, 1)>(vb);
  asm volatile("s_waitcnt lgkmcnt(0)" ::: "memory"); SBAR();
#define PK(L, H) (bf16x8){L[0], L[1], L[2], L[3], H[0], H[1], H[2], H[3]}
  od = __builtin_amdgcn_mfma_f32_32x32x16_bf16(pa0, PK(l0, h0), od, 0, 0, 0);
  od = __builtin_amdgcn_mfma_f32_32x32x16_bf16(pa1, PK(l1, h1), od, 0, 0, 0);
  od = __builtin_amdgcn_mfma_f32_32x32x16_bf16(pa2, PK(l2, h2), od, 0, 0, 0);
  od = __builtin_amdgcn_mfma_f32_32x32x16_bf16(pa3, PK(l3, h3), od, 0, 0, 0);
#undef PK
}
__device__ __forceinline__ void pv_d0(f32x16* o, int vb, bf16x8 pa0, bf16x8 pa1, bf16x8 pa2, bf16x8 pa3) {
  pv_one<0>(o[0], vb, pa0, pa1, pa2, pa3); pv_one<1>(o[1], vb, pa0, pa1, pa2, pa3); pv_one<2>(o[2], vb, pa0, pa1, pa2, pa3); pv_one<3>(o[3], vb, pa0, pa1, pa2, pa3);
}
template <typename TQ>
__device__ __forceinline__ void attn_dense_body(const TQ* __restrict__ Qb, const bf16* __restrict__ Kh, const bf16* __restrict__ Vh,
                                                bf16* ZSb, int seq, char* lds, int tid_) {
  using St = Stage<bf16>; using SQ = Stage<TQ>;
  asm volatile("" : "+v"(tid_));
  const int tid = tid_, wid = tid >> 6, lane = tid & 63, r32 = lane & 31, hi = lane >> 5;
  bf16* V_lds = (bf16*)lds; bf16* K_lds = (bf16*)(lds + 2 * SHM_V);
  float* ws = (float*)(lds + 2 * SHM_V + 2 * SHM_K) + wid * 64; float* li_l = ws; float* al_l = ws + 32;
  float m_reg = -1e30f, l_reg = 0; f32x16 o[4] = {}; bf16x8 qr[8];
  const TQ* Qw = Qb + (long)(wid * QBLK + r32) * LDQ + hi * 8;
#pragma unroll
  for (int d0 = 0; d0 < 8; ++d0) qr[d0] = SQ::tobf(SQ::ld8(Qw + d0 * 16));
  const int sr = tid >> 4, sc = (tid & 15) * 8, vst0 = v_st(sr, sc), vst1 = v_st(32 + sr, sc);
  const int vb0 = (int)(uintptr_t)V_lds + v_rd_base(lane);
  struct { typename St::T vs0, vs1, ks0, ks1; } sr_[SDEPTH];
#define SLOAD(i, k0) do { sr_[i].vs0 = St::ld8(&Vh[(long)((k0) + sr) * LDK + sc]); sr_[i].vs1 = St::ld8(&Vh[(long)((k0) + 32 + sr) * LDK + sc]); \
    sr_[i].ks0 = St::ld8(&Kh[(long)((k0) + sr) * LDK + sc]); sr_[i].ks1 = St::ld8(&Kh[(long)((k0) + 32 + sr) * LDK + sc]); } while (0)
#define SWRITE(b, i) do { *(bf16x8*)((char*)V_lds + (b) * SHM_V + vst0) = St::tobf(sr_[i].vs0);          \
    *(bf16x8*)((char*)V_lds + (b) * SHM_V + vst1) = St::tobf(sr_[i].vs1); int kc = sc * 2;               \
    *(bf16x8*)((char*)K_lds + (b) * SHM_K + KSWZ(sr, kc)) = St::tobf(sr_[i].ks0);                       \
    *(bf16x8*)((char*)K_lds + (b) * SHM_K + KSWZ(32 + sr, kc)) = St::tobf(sr_[i].ks1); } while (0)
#define SWAIT() do { if constexpr (SDEPTH == 2) asm volatile("s_waitcnt vmcnt(4)" ::: "memory"); else asm volatile("s_waitcnt vmcnt(0)" ::: "memory"); } while (0)
#define RESC(a) do { if (__any((a) < 1.f)) { if (hi == 0) al_l[r32] = (a); asm volatile("s_waitcnt lgkmcnt(0)" ::: "memory"); \
    for (int d = 0; d < 4; ++d) for (int r = 0; r < 16; ++r) o[d][r] *= al_l[crow(r, hi)]; } } while (0)
  f32x16 pA0, pA1, pB0, pB1; float mnA, mnB, alA, alB; bf16x8 pa0, pa1, pa2, pa3; const int NT = seq / KVBLK;
  constexpr int SE = 0, SO = SDEPTH - 1;
  SLOAD(SE, 0); asm volatile("s_waitcnt vmcnt(0)" ::: "memory"); SWRITE(0, SE); __syncthreads();
  qkt(pA0, pA1, K_lds, qr, r32, hi); partialSM(pA0, pA1, m_reg, mnA, alA);
  SLOAD(SO, KVBLK); if constexpr (SDEPTH == 2) { if (2 < NT) SLOAD(SE, 2 * KVBLK); }
  SWAIT(); SWRITE(1, SO); __syncthreads();
  for (int j = 1; j + 1 < NT; j += 2) {
    SBAR(); qkt(pB0, pB1, (bf16*)((char*)K_lds + SHM_K), qr, r32, hi);
    finishSM(pA0, pA1, alA, l_reg, pa0, pa1, pa2, pa3); SBAR();
    SLOAD(SO, (j + SDEPTH) * KVBLK); SBAR();
    pv_d0(o, vb0, pa0, pa1, pa2, pa3); partialSM(pB0, pB1, m_reg, mnB, alB);
    __syncthreads(); SWAIT(); SWRITE(0, SE);
    RESC(alB); __syncthreads();
    SBAR(); qkt(pA0, pA1, K_lds, qr, r32, hi);
    finishSM(pB0, pB1, alB, l_reg, pa0, pa1, pa2, pa3); SBAR();
    if (SDEPTH == 1 || j + 3 < NT) SLOAD(SE, (j + 1 + SDEPTH) * KVBLK); SBAR();
    pv_d0(o, vb0 + (int)SHM_V, pa0, pa1, pa2, pa3); partialSM(pA0, pA1, m_reg, mnA, alA);
    __syncthreads(); SWAIT(); SWRITE(1, SO);
    RESC(alA); __syncthreads();
  }
  SBAR(); qkt(pB0, pB1, (bf16*)((char*)K_lds + SHM_K), qr, r32, hi);
  finishSM(pA0, pA1, alA, l_reg, pa0, pa1, pa2, pa3); SBAR();
  pv_d0(o, vb0, pa0, pa1, pa2, pa3); partialSM(pB0, pB1, m_reg, mnB, alB);
  __syncthreads(); RESC(alB);
  finishSM(pB0, pB1, alB, l_reg, pa0, pa1, pa2, pa3); SBAR();
  pv_d0(o, vb0 + (int)SHM_V, pa0, pa1, pa2, pa3);
  if (hi == 0) li_l[r32] = l_reg; asm volatile("s_waitcnt lgkmcnt(0)" ::: "memory");
  float rli[16];
#pragma unroll
  for (int r = 0; r < 16; ++r) rli[r] = __builtin_amdgcn_rcpf(li_l[crow(r, hi)]);
  bf16* Zw = ZSb + (long)(wid * QBLK) * LDO;
#pragma unroll
  for (int r = 0; r < 16; ++r) { int orow = crow(r, hi);
    for (int d0 = 0; d0 < 4; ++d0) { bf16* zp = Zw + (long)orow * LDO + d0 * 32 + r32; const float zs = __builtin_bit_cast(float, (unsigned)(*zp) << 16);
      const float a2 = o[d0][r] * rli[r] * zs; unsigned ub = __builtin_bit_cast(unsigned, a2); *zp = (bf16)((ub + 0x7fffu + ((ub >> 16) & 1u)) >> 16); } }
  __syncthreads();
#undef SLOAD
#undef SWRITE
#undef SWAIT
#undef RESC
}
}
#define XB_TMO      128
#define XB_XCNT(j)  (256  + 64 * (j))
#define XB_XSUB(j)  (1280 + 64 * (j))
#define XB_XGEN(j)  (2304 + 64 * (j))
#define XB_TOP      3328
#define XB_TOPGEN   3392
#define XCD_BAR_WORDS 3456
#define XB_SPIN_CAP (1u << 18)

__device__ __forceinline__ unsigned xb_ld(unsigned* p)              { return __hip_atomic_load(p, __ATOMIC_RELAXED, __HIP_MEMORY_SCOPE_AGENT); }
__device__ __forceinline__ unsigned xb_add(unsigned* p, unsigned v) { return __hip_atomic_fetch_add(p, v, __ATOMIC_RELAXED, __HIP_MEMORY_SCOPE_AGENT); }
__device__ __forceinline__ unsigned xb_xcc_id() { return (unsigned)__builtin_amdgcn_s_getreg((3 << 11) | 20) & 0xFu; }
#define XB_SPIN(cond, bar) do { unsigned _sp = 0; while (cond) { __builtin_amdgcn_s_sleep(1); \
    if ((++_sp & 255u) == 0u) { if (xb_ld(&(bar)[XB_TMO])) break; if (_sp > XB_SPIN_CAP) { atomicAdd(&(bar)[XB_TMO], 1u); break; } } } } while (0)

struct XcdBarrier {
    unsigned* bar; unsigned x;
    volatile LAS unsigned* st;
};

__device__ __forceinline__ XcdBarrier xcd_barrier_post(unsigned* bar, volatile LAS unsigned* st, bool t0) {
    XcdBarrier b; b.bar = bar; b.x = xb_xcc_id(); b.st = st;
    if (t0) (void)xb_add(&bar[XB_XCNT(b.x)], 1u);
    return b;
}
__device__ __forceinline__ void xcd_barrier_complete(unsigned* bar, unsigned x, unsigned& nloc, unsigned& nx) {
    const unsigned G = gridDim.x * gridDim.y * gridDim.z;
    unsigned sum, cnt, mine, sp = 0u;
    for (;;) {
        sum = 0u; cnt = 0u; mine = 0u;
#pragma unroll
        for (unsigned j = 0; j < 16; ++j) { const unsigned c = xb_ld(&bar[XB_XCNT(j)]); sum += c; cnt += (c > 0u) ? 1u : 0u; mine = (j == x) ? c : mine; }
        if (sum == G) break;
        __builtin_amdgcn_s_sleep(1);
        if ((++sp & 255u) == 0u) { if (xb_ld(&bar[XB_TMO])) break; if (sp > XB_SPIN_CAP) { atomicAdd(&bar[XB_TMO], 1u); break; } }
    }
    nloc = mine > 0u ? mine : 1u; nx = cnt > 0u ? cnt : 1u;
}

__device__ __forceinline__ void xcd_barrier(const XcdBarrier& b, bool t0) {
    asm volatile("s_waitcnt vmcnt(0)" ::: "memory");
    __syncthreads();
    if (t0) {
        unsigned* bar = b.bar;
        __builtin_amdgcn_s_waitcnt(0);
        unsigned nloc = b.st[0], nx = b.st[1];
        if (nloc == 0u) { xcd_barrier_complete(bar, b.x, nloc, nx); b.st[0] = nloc; b.st[1] = nx; }
        const unsigned old = xb_add(&bar[XB_XSUB(b.x)], 1u);
        const unsigned gen = old / nloc;
        if (old + 1u == (gen + 1u) * nloc) {
            __builtin_amdgcn_fence(__ATOMIC_RELEASE, "agent");
            asm volatile("s_waitcnt vmcnt(0)" ::: "memory");
            const unsigned og = xb_add(&bar[XB_TOP], 1u);
            const unsigned tg = og / nx;
            if (og + 1u == (tg + 1u) * nx) xb_add(&bar[XB_TOPGEN], 1u);
            else XB_SPIN(xb_ld(&bar[XB_TOPGEN]) == tg, bar);
            __builtin_amdgcn_fence(__ATOMIC_ACQUIRE, "agent");
            xb_add(&bar[XB_XGEN(b.x)], 1u);
            asm volatile("s_waitcnt vmcnt(0)" ::: "memory");
        } else {
            XB_SPIN(xb_ld(&bar[XB_XGEN(b.x)]) == gen, bar);
            __builtin_amdgcn_fence(__ATOMIC_ACQUIRE, "agent");
            asm volatile("s_waitcnt vmcnt(0)" ::: "memory");
        }
    }
    __syncthreads();
}
struct Args {
    const float *x, *c, *ctx, *c_ctx, *norm_g, *ada_w, *ada_b, *hy_w_in, *hy_conv_w, *hy_conv_b, *fw1, *fb1, *fw2, *fb2, *fw3, *fb3, *fw4, *freq, *hy_d, *hy_w_out,
                *at_w_in, *at_q_g, *at_k_g, *at_w_out;
    float* out; unsigned char* ws;
};

template <int MODE> __device__ __forceinline__ int dest_row(int n) {
    if (MODE == 1) { const int s = n >> 11, c = n & 2047, pn = c >> 6, cl = c & 63; return pn * 256 + 128 * (s >> 1) + 32 * (cl >> 4) + 8 * ((cl >> 2) & 3) + 4 * (s & 1) + (cl & 3); }
    if (MODE == 2) { if (n >= 2560) return n; const int hh = n >> 7, dim = n & 127, quarter = dim >> 5, rem = dim & 31;
        return hh * 128 + 32 * (rem >> 3) + 8 * ((rem >> 1) & 3) + 4 * (quarter >> 1) + 2 * (quarter & 1) + (rem & 1); }
    return n;
}
template <int MODE> __device__ __forceinline__ void transpose_item(const float* W, int K, int N, bf16_t* WT, LAS float* scr, int item, int lane) {
    const int nblk = N / 32, kb = item / nblk, nb = item % nblk, k0 = 64 * kb, n0 = 32 * nb;
#pragma unroll 8
    for (int i = 0; i < 32; ++i) { const int kk = 2 * i + (lane >> 5); scr[kk * 33 + (lane & 31)] = W[(size_t)(k0 + kk) * N + n0 + (lane & 31)]; }
    asm volatile("s_waitcnt lgkmcnt(0)" ::: "memory");
    const int c = lane & 7;
#pragma unroll
    for (int j = 0; j < 4; ++j) { const int n = (lane >> 3) + 8 * j; const LAS float* s = scr + (8 * c) * 33 + n;
        u32x4 o; o.x = pk2(s[0 * 33], s[1 * 33]); o.y = pk2(s[2 * 33], s[3 * 33]); o.z = pk2(s[4 * 33], s[5 * 33]); o.w = pk2(s[6 * 33], s[7 * 33]);
        *(u32x4*)(WT + (size_t)dest_row<MODE>(n0 + n) * K + k0 + 8 * c) = o; }
    asm volatile("s_waitcnt lgkmcnt(0)" ::: "memory");
}
__device__ __forceinline__ float red_rev(float x) { const float n = rintf(x * 0.15915494309189535f); float r = fmaf(n, -6.28125f, x); r = fmaf(n, -0.0019353071795864769f, r); return r * 0.15915494309189535f; }
__device__ __forceinline__ float hsin(float x) { return __builtin_amdgcn_sinf(red_rev(x)); }
__device__ __forceinline__ float hcos(float x) { return __builtin_amdgcn_cosf(red_rev(x)); }
__device__ __forceinline__ float rdlane(float v, int k) { return __builtin_bit_cast(float, __builtin_amdgcn_readlane(__builtin_bit_cast(int, v), k)); }
__device__ __forceinline__ void filt_item(const Args& A, int L, int i, float* h3row, int lane) {
    const float t = (float)i / (float)(L - 1);
    const float w = 6.283185307179586f * (float)i / (float)L;
    float zf = 0.f;
    if (lane == 0) zf = t;
    else if (lane <= 32) { const int mi = (lane - 1) & 15; const float fr = 1e-4f + (float)mi * ((15.0f - 1e-4f) / 15.0f); zf = (lane <= 16) ? hcos(fr * w) : -hsin(fr * w); }
    const float fq = A.freq[lane];
    float a = A.fb1[lane];
#pragma unroll 3
    for (int k = 0; k < 33; ++k) a += rdlane(zf, k) * A.fw1[k * 64 + lane];
    float h = hsin(fq * a);
    a = A.fb2[lane];
#pragma unroll 8
    for (int k = 0; k < 64; ++k) a += rdlane(h, k) * A.fw2[k * 64 + lane];
    h = hsin(fq * a);
    a = A.fb3[lane];
#pragma unroll 8
    for (int k = 0; k < 64; ++k) a += rdlane(h, k) * A.fw3[k * 64 + lane];
    h = hsin(fq * a);
    h3row[lane] = h;
}
__device__ __forceinline__ void norm_row(const float* xrow, const float* g, const float* mod, bf16_t* orow, int lane) {
    const f32x4* xr = (const f32x4*)xrow + lane;
    f32x4 v[4]; float s = 0.f;
#pragma unroll
    for (int j = 0; j < 4; ++j) { v[j] = xr[64 * j]; s += (v[j].x * v[j].x + v[j].y * v[j].y) + (v[j].z * v[j].z + v[j].w * v[j].w); }
    const float rstd = rsqrtf(wave_sum(s) * (1.f / DM) + EPSN);
#pragma unroll
    for (int j = 0; j < 4; ++j) { const int col = 4 * lane + 256 * j;
        const f32x4 gg = *(const f32x4*)(g + col), sh = *(const f32x4*)(mod + col), sc = *(const f32x4*)(mod + 1024 + col);
        const f32x4 h = v[j] * rstd * gg * (1.f + sc) + sh;
        u32x2 o; o.x = pk2(h.x, h.y); o.y = pk2(h.z, h.w); *(u32x2*)(orow + col) = o; }
}

typedef float cf __attribute__((ext_vector_type(2)));
__device__ __forceinline__ cf cmul(cf a, cf b) { return {a.x * b.x - a.y * b.y, a.x * b.y + a.y * b.x}; }
template <int SGN> __device__ __forceinline__ cf mulw4(cf a) { return SGN > 0 ? cf{-a.y, a.x} : cf{a.y, -a.x}; }
template <int SGN> __device__ __forceinline__ void fft4(cf& a0, cf& a1, cf& a2, cf& a3) {
    const cf s02 = a0 + a2, d02 = a0 - a2, s13 = a1 + a3, d13 = mulw4<SGN>(a1 - a3);
    a0 = s02 + s13; a1 = d02 + d13; a2 = s02 - s13; a3 = d02 - d13;
}
template <int SGN> __device__ __forceinline__ cf tw(float frac) { return {__builtin_amdgcn_cosf(frac), (float)SGN * __builtin_amdgcn_sinf(frac)}; }
template <int SGN> __device__ __forceinline__ void fft16(cf (&v)[16]) {
#pragma unroll
    for (int b = 0; b < 4; ++b) fft4<SGN>(v[b], v[4 + b], v[8 + b], v[12 + b]);
    constexpr float C1 = 0.92387953251128674f, S1 = 0.38268343236508977f, C2 = 0.70710678118654752f;
    const float sg = (float)SGN;
    v[4 * 1 + 1] = cmul(v[4 * 1 + 1], cf{C1, sg * S1});
    v[4 * 1 + 2] = cmul(v[4 * 1 + 2], cf{C2, sg * C2});
    v[4 * 1 + 3] = cmul(v[4 * 1 + 3], cf{S1, sg * C1});
    v[4 * 2 + 1] = cmul(v[4 * 2 + 1], cf{C2, sg * C2});
    v[4 * 2 + 2] = mulw4<SGN>(v[4 * 2 + 2]);
    v[4 * 2 + 3] = cmul(v[4 * 2 + 3], cf{-C2, sg * C2});
    v[4 * 3 + 1] = cmul(v[4 * 3 + 1], cf{S1, sg * C1});
    v[4 * 3 + 2] = cmul(v[4 * 3 + 2], cf{-C2, sg * C2});
    v[4 * 3 + 3] = cmul(v[4 * 3 + 3], cf{-C1, -sg * S1});
#pragma unroll
    for (int c = 0; c < 4; ++c) fft4<SGN>(v[4 * c + 0], v[4 * c + 1], v[4 * c + 2], v[4 * c + 3]);
}
template <int SGN> __device__ __forceinline__ void fft_run(cf (&v)[32], LAS cf* L, int tid) {
    asm volatile("" : "+v"(tid));
    const int pb = tid + (tid >> 4);
#pragma unroll
    for (int i = 0; i < 2; ++i) { cf t[16];
#pragma unroll
        for (int q = 0; q < 16; ++q) t[q] = v[i + 2 * q];
        fft16<SGN>(t); LAS cf* Lw = L + 17 * tid + 8704 * i;
#pragma unroll
        for (int p = 0; p < 16; ++p) Lw[p] = t[4 * (p & 3) + (p >> 2)];
        asm volatile("" ::: "memory"); __builtin_amdgcn_sched_barrier(0); }
    __syncthreads();
#pragma unroll
    for (int ps = 0; ps < 2; ++ps) { const int Ns = ps ? 256 : 16;
#pragma unroll
        for (int i = 0; i < 2; ++i)
#pragma unroll
            for (int q = 0; q < 16; ++q) v[i * 16 + q] = L[pb + 544 * i + 1088 * q];
        __syncthreads();
#pragma unroll
        for (int i = 0; i < 2; ++i) { const int j = tid + 512 * i, jm = j & (Ns - 1); const float f1 = (float)jm / (float)(Ns * 16);
            cf t[16]; t[0] = v[i * 16];
#pragma unroll
            for (int q = 1; q < 16; ++q) t[q] = cmul(v[i * 16 + q], tw<SGN>(f1 * (float)q));
            fft16<SGN>(t); const int base = (j / Ns) * Ns * 16 + jm; LAS cf* Lw = L + base + (base >> 4);
#pragma unroll
            for (int p = 0; p < 16; ++p) Lw[(Ns + (Ns >> 4)) * p] = t[4 * (p & 3) + (p >> 2)];
            asm volatile("" ::: "memory"); __builtin_amdgcn_sched_barrier(0); }
        __syncthreads();
    }
#pragma unroll
    for (int i = 0; i < 8; ++i) { const int j = tid + 512 * i; const float f1 = (float)j * (1.0f / 16384.0f);
        cf a0 = L[pb + 544 * i], a1 = L[pb + 544 * i + 4352], a2 = L[pb + 544 * i + 8704], a3 = L[pb + 544 * i + 13056];
        a1 = cmul(a1, tw<SGN>(f1)); a2 = cmul(a2, tw<SGN>(2.f * f1)); a3 = cmul(a3, tw<SGN>(3.f * f1));
        fft4<SGN>(a0, a1, a2, a3); v[i] = a0; v[i + 8] = a1; v[i + 16] = a2; v[i + 24] = a3; if (i & 1) __builtin_amdgcn_sched_barrier(0); }
    __syncthreads();
}
__device__ __forceinline__ float block_sum(float v, LAS float* red, int tid) {
    v = wave_sum(v);
    if ((tid & 63) == 0) red[tid >> 6] = v;
    __syncthreads();
    float s = 0.f;
#pragma unroll
    for (int i = 0; i < 8; ++i) s += red[i];
    __syncthreads();
    return s;
}
#ifndef PH
#define PH 0x7ff
#endif
__device__ __forceinline__ const Args& kargs_ref() {
#if defined(__HIP_DEVICE_COMPILE__)
    typedef const __attribute__((address_space(4))) Args* KArgP;
    KArgP p = (KArgP)__builtin_amdgcn_kernarg_segment_ptr(); asm volatile("" : "+s"(p)); return *(const Args*)p;
#else
    static Args dummy; return dummy;
#endif
}
__global__ void __launch_bounds__(NTHR, 2) mk_fwd(Args Akern) {
    extern __shared__ __attribute__((aligned(16))) unsigned char lds_raw[];
    cg::grid_group grid = cg::this_grid();
    LAS unsigned char* lds = (LAS unsigned char*)lds_raw;
    const int G = gridDim.x, bx = blockIdx.x;
    const int wave_s = __builtin_amdgcn_readfirstlane((int)threadIdx.x >> 6);
    if (threadIdx.x < 2) ((LAS unsigned*)(lds + LDS_MISC))[threadIdx.x] = 0u;
    __syncthreads();
    (void)xcd_barrier_post((unsigned*)(kargs_ref().ws + WS_CTL), (volatile LAS unsigned*)(lds + LDS_MISC), threadIdx.x == 0);
#define GRID_BAR() do { int tb_; asm volatile("v_mbcnt_lo_u32_b32 %0, -1, 0\n\tv_mbcnt_hi_u32_b32 %0, -1, %0" : "=v"(tb_)); XcdBarrier xb_; xb_.bar = (unsigned*)(kargs_ref().ws + WS_CTL); xb_.x = xb_xcc_id(); \
        xb_.st = (volatile LAS unsigned*)(lds + LDS_MISC); xcd_barrier(xb_, wave_s == 0 && tb_ == 0); } while (0)
#define MOD ((float*)(ws + WS_MOD))
#define H3 ((float*)(ws + WS_H3))
#define H3C ((float*)(ws + WS_H3C))
#define ROPE ((float*)(ws + WS_ROPE))
#define KTC ((float*)(ws + WS_KTC))
#define X1C ((float*)(ws + WS_X1C))
#define WIN ((bf16_t*)(ws + WS_WIN))
#define WOUT ((bf16_t*)(ws + WS_WOUT))
#define AWIN ((bf16_t*)(ws + WS_AWIN))
#define AWOUT ((bf16_t*)(ws + WS_AWOUT))
#define H ((bf16_t*)(ws + WS_H))
#define S ((float*)(ws + WS_S))
#define UT ((bf16_t*)(ws + WS_UT))
#define GB ((bf16_t*)(ws + WS_G))
#define Q ((bf16_t*)(ws + WS_Q))
#define ZS ((bf16_t*)(ws + WS_ZS))
#define KB ((bf16_t*)(ws + WS_KB))
#define VB ((bf16_t*)(ws + WS_VB))
#define KT ((bf16_t*)A.out)
    if constexpr ((PH >> 0) & 1) {
        const Args& A = kargs_ref(); unsigned char* ws = A.ws; int tid_; asm volatile("v_mbcnt_lo_u32_b32 %0, -1, 0\n\tv_mbcnt_hi_u32_b32 %0, -1, %0" : "=v"(tid_)); tid_ += wave_s * 64; const int tid = tid_, lane = tid & 63, wave = __builtin_amdgcn_readfirstlane(tid >> 6), gw = bx * 8 + wave, NGW = G * 8; (void)lane; (void)gw; (void)NGW;
        LAS float* scr = (LAS float*)(lds + wave * 8448);
        constexpr int I0 = 16 * 256, I1 = 16 * 160, I2 = 32 * 32, I3 = 32 * 32;
        for (int it = gw; it < I0 + I1 + I2 + I3; it += NGW) {
            int r = it;
            if (r < I0) { transpose_item<1>(A.hy_w_in, 1024, 8192, WIN, scr, r, lane); continue; } r -= I0;
            if (r < I1) { transpose_item<2>(A.at_w_in, 1024, 5120, AWIN, scr, r, lane); continue; } r -= I1;
            if (r < I2) { transpose_item<0>(A.hy_w_out, 2048, 1024, WOUT, scr, r, lane); continue; } r -= I2;
            transpose_item<0>(A.at_w_out, 2048, 1024, AWOUT, scr, r, lane);
        }
        for (int it = gw; it < LSEQ + CTX; it += NGW) { if (it < LSEQ) filt_item(A, LSEQ, it, H3 + (size_t)it * 64, lane); else filt_item(A, CTX, it - LSEQ, H3C + (size_t)(it - LSEQ) * 64, lane); }
        for (int it = bx * NTHR + tid; it < 128 * 32; it += G * NTHR) { const int pos = it >> 5, f = it & 31; const float inv = __builtin_amdgcn_exp2f(-(float)f * (13.287712379549449f / 32.0f)); const float ang = (float)pos * inv;
            ROPE[it * 2] = hcos(ang); ROPE[it * 2 + 1] = hsin(ang); }
        __syncthreads();
        LAS float* part = (LAS float*)lds;
        for (int it = bx; it < 96; it += G) {
            const int l = it / 48, n = (it % 48) * 64 + lane;
            const float* W = A.ada_w + (size_t)l * 1024 * 3072 + n;
            float a0 = 0.f, a1 = 0.f, a2 = 0.f;
#pragma unroll 8
            for (int k = wave * 128; k < wave * 128 + 128; ++k) { const float wv = W[(size_t)k * 3072];
                a0 += silu_f(A.c[k]) * wv; a1 += silu_f(A.c[1024 + k]) * wv; a2 += silu_f(A.c_ctx[k]) * wv; }
            part[(wave * 3 + 0) * 64 + lane] = a0; part[(wave * 3 + 1) * 64 + lane] = a1; part[(wave * 3 + 2) * 64 + lane] = a2;
            __syncthreads();
            if (wave < 3) { float s = A.ada_b[l * 3072 + n];
#pragma unroll
                for (int w8 = 0; w8 < 8; ++w8) s += part[(w8 * 3 + wave) * 64 + lane];
                MOD[(l * 3 + wave) * 3072 + n] = s; }
            __syncthreads();
        }
    }
    grid.sync();
    if constexpr ((PH >> 1) & 1) {
        const Args& A = kargs_ref(); unsigned char* ws = A.ws; int tid_; asm volatile("v_mbcnt_lo_u32_b32 %0, -1, 0\n\tv_mbcnt_hi_u32_b32 %0, -1, %0" : "=v"(tid_)); tid_ += wave_s * 64; const int tid = tid_, lane = tid & 63, wave = __builtin_amdgcn_readfirstlane(tid >> 6), gw = bx * 8 + wave, NGW = G * 8; (void)lane; (void)gw; (void)NGW;
        for (int m = gw; m < MALL; m += NGW) { const int src = m < LSEQ ? 0 : (m < MLAT ? 1 : 2);
            const float* xr = m < MLAT ? A.x + (size_t)m * DM : A.ctx + (size_t)(m - MLAT) * DM;
            norm_row(xr, A.norm_g, MOD + src * 3072, H + (size_t)m * DM, lane); }
        LAS float* Wl = (LAS float*)lds;
        for (int it = bx; it < 256 + 16; it += G) {
            const bool isctx = it >= 256; const int cgp = isctx ? it - 256 : (it & 15), tb = isctx ? 0 : (it >> 4);
            __syncthreads();
            for (int e = tid; e < 64 * 256; e += NTHR) { const int k = e >> 8, col = e & 255; Wl[col * 68 + k] = A.fw4[(size_t)k * 4096 + cgp * 256 + col]; }
            __syncthreads();
            const int L = isctx ? CTX : LSEQ; const int t = isctx ? (tid & 255) : tb * 512 + tid;
            const float* hsrc = (isctx ? H3C : H3) + (size_t)t * 64;
            f32x4 hr[16];
#pragma unroll
            for (int k4 = 0; k4 < 16; ++k4) hr[k4] = *(const f32x4*)(hsrc + 4 * k4);
            const float tn = (float)t / (float)(L - 1);
            const int cbeg = isctx ? (tid >> 8) * 128 : 0, ncol = isctx ? 128 : 256;
            for (int cc = cbeg; cc < cbeg + ncol; ++cc) {
                f32x4 a4 = {0.f, 0.f, 0.f, 0.f};
#pragma unroll
                for (int k4 = 0; k4 < 16; ++k4) a4 += hr[k4] * *(const LAS f32x4*)(Wl + cc * 68 + 4 * k4);
                const float a = (a4.x + a4.y) + (a4.z + a4.w);
                const int n = cgp * 256 + cc, dir = n >> 11, ch = n & 2047;
                const float delta = fabsf(MIN_DECAY + (float)ch * ((MAX_DECAY - MIN_DECAY) / 2047.0f));
                const float val = a * expf(-tn * delta);
                if (isctx) KTC[(size_t)(ch * 2 + dir) * 256 + t] = val; else KT[(size_t)(ch * 2 + dir) * LSEQ + t] = (bf16_t)f2bf(val);
            }
        }
        __syncthreads();
    }
    GRID_BAR();
    if constexpr ((PH >> 2) & 1) {
        const Args& A = kargs_ref(); unsigned char* ws = A.ws; int tid_; asm volatile("v_mbcnt_lo_u32_b32 %0, -1, 0\n\tv_mbcnt_hi_u32_b32 %0, -1, %0" : "=v"(tid_)); tid_ += wave_s * 64; const int tid = tid_, lane = tid & 63, wave = __builtin_amdgcn_readfirstlane(tid >> 6), gw = bx * 8 + wave, NGW = G * 8; (void)lane; (void)gw; (void)NGW;
        pg8::Gemm g{H, WIN, MALL, 8192, 1024}; pg8::StaticOrder So; So.init(MALL, 8192, G, bx);
        pg8::EpiHy E{A.hy_conv_w, A.hy_conv_b, UT, GB, S};
        pg8::gemm_phase<pg8::EpiHy, pg8::StaticOrder, true, true>(lds, g, So, E, tid_);
    }
    GRID_BAR();
    if constexpr ((PH >> 3) & 1) {
        const Args& A = kargs_ref(); unsigned char* ws = A.ws; int tid_; asm volatile("v_mbcnt_lo_u32_b32 %0, -1, 0\n\tv_mbcnt_hi_u32_b32 %0, -1, %0" : "=v"(tid_)); tid_ += wave_s * 64; const int tid = tid_, lane = tid & 63, wave = __builtin_amdgcn_readfirstlane(tid >> 6), gw = bx * 8 + wave, NGW = G * 8; (void)lane; (void)gw; (void)NGW;
        for (int it = bx * NTHR + tid; it < NSTRIP * 2 * 512; it += G * NTHR) {
            const int c0 = (it & 511) * 4, ri = it >> 9, strip = ri >> 1, which = ri & 1;
            const int row = strip * 64 + (which ? 63 : 0);
            const bool seq_start = (row & (LSEQ - 1)) == 0 || (row >= MLAT && (row & 255) == 0);
            const bool seq_end = ((row + 1) & (LSEQ - 1)) == 0 || (row >= MLAT && ((row + 1) & 255) == 0);
            const float* Sp; const float* Sc; const float* Sn; bool zp = false, zn = false;
            if (which == 0) { zp = seq_start; Sp = S + (size_t)(((zp ? strip : strip - 1) * 4 + 3) * 4) * 2048; Sc = S + (size_t)((strip * 4 + 0) * 4) * 2048; Sn = S + (size_t)((strip * 4 + 1) * 4) * 2048; }
            else { zn = seq_end; Sp = S + (size_t)((strip * 4 + 2) * 4) * 2048; Sc = S + (size_t)((strip * 4 + 3) * 4) * 2048; Sn = S + (size_t)(((zn ? strip : strip + 1) * 4 + 0) * 4) * 2048; }
            f32x4 cv[3];
#pragma unroll
            for (int s = 0; s < 3; ++s) {
                f32x4 pv = *(const f32x4*)(Sp + s * 2048 + c0), cur = *(const f32x4*)(Sc + s * 2048 + c0), nx = *(const f32x4*)(Sn + s * 2048 + c0);
                if (zp) pv = (f32x4){0.f, 0.f, 0.f, 0.f}; if (zn) nx = (f32x4){0.f, 0.f, 0.f, 0.f};
                cv[s] = *(const f32x4*)(A.hy_conv_w + 0 * 6144 + s * 2048 + c0) * pv + *(const f32x4*)(A.hy_conv_w + 1 * 6144 + s * 2048 + c0) * cur
                      + *(const f32x4*)(A.hy_conv_w + 2 * 6144 + s * 2048 + c0) * nx + *(const f32x4*)(A.hy_conv_b + s * 2048 + c0);
            }
            const f32x4 z = *(const f32x4*)(Sc + 3 * 2048 + c0);
            const f32x4 uu = cv[1] * cv[2]; f32x4 g;
#pragma unroll
            for (int j = 0; j < 4; ++j) { g[j] = cv[0][j] * silu_f(z[j]); UT[(size_t)(c0 + j) * MALL + row] = (bf16_t)f2bf(uu[j]); }
            u32x2 gw2; gw2.x = pk2(g[0], g[1]); gw2.y = pk2(g[2], g[3]);
            *(u32x2*)(GB + (size_t)row * 2048 + c0) = gw2;
        }
    }
    GRID_BAR();
    if constexpr ((PH >> 4) & 1) {
        const Args& A = kargs_ref(); unsigned char* ws = A.ws; int tid_; asm volatile("v_mbcnt_lo_u32_b32 %0, -1, 0\n\tv_mbcnt_hi_u32_b32 %0, -1, %0" : "=v"(tid_)); tid_ += wave_s * 64; const int tid = tid_, lane = tid & 63, wave = __builtin_amdgcn_readfirstlane(tid >> 6), gw = bx * 8 + wave, NGW = G * 8; (void)lane; (void)gw; (void)NGW;
        LAS cf* L = (LAS cf*)lds; LAS float* red = (LAS float*)(lds + 139264); LAS float* Lf = (LAS float*)lds;
        for (int ch = bx; ch < EH; ch += G) {
            int tl = tid_; asm volatile("" : "+v"(tl));
#define tid tl
            cf v[32]; cf* KS = (cf*)(ws + WS_S) + (size_t)bx * 16384 + tid;
            const bf16_t* kf = KT + (size_t)ch * 2 * LSEQ; const bf16_t* kb = kf + LSEQ;
            float asum = 0.f;
#pragma unroll
            for (int m = 0; m < 32; ++m) { const int pos = tid + 512 * m; float kv;
                if (m < 16) kv = bf2f(kf[pos]); else kv = (pos == LSEQ) ? 0.f : bf2f(kb[2 * LSEQ - pos]);
                asum += fabsf(kv); v[m] = cf{kv, 0.f}; }
            const float tot = block_sum(asum, red, tid);
            fft_run<-1>(v, L, tid);
            const float sc = 1.0f / (tot * 16384.0f);
#pragma unroll
            for (int m = 0; m < 32; ++m) KS[512 * m] = cf{v[m].x * sc, v[m].y * sc};
            asm volatile("" : "+v"(tl));
            bf16_t* u0 = UT + (size_t)ch * MALL;
#pragma unroll
            for (int m = 0; m < 32; ++m) { const int pos = tid + 512 * m; v[m] = (m < 16) ? cf{bf2f(u0[pos]), bf2f(u0[LSEQ + pos])} : cf{0.f, 0.f}; }
            fft_run<-1>(v, L, tid);
#pragma unroll
            for (int m = 0; m < 32; ++m) v[m] = cmul(v[m], KS[512 * m]);
            fft_run<1>(v, L, tid);
            asm volatile("" : "+v"(tl));
            const float dsk = A.hy_d[ch];
#pragma unroll
            for (int m = 0; m < 16; ++m) { const int pos = tid + 512 * m; const float ua = bf2f(u0[pos]), ub = bf2f(u0[LSEQ + pos]);
                u0[pos] = (bf16_t)f2bf(v[m].x + dsk * ua); u0[LSEQ + pos] = (bf16_t)f2bf(v[m].y + dsk * ub); }
            asm volatile("" : "+v"(tl));
            const float uc = bf2f(u0[MLAT + tid]); const float kc = KTC[(size_t)ch * 512 + tid];
            Lf[tid] = uc; Lf[512 + tid] = kc;
            const float totc = block_sum((tid == 256) ? 0.f : fabsf(kc), red, tid);
            const int b = tid >> 8, t = tid & 255; float acc = 0.f;
            for (int s = 0; s < 256; ++s) { const float kk = (s <= t) ? Lf[512 + (t - s)] : Lf[768 + (s - t)]; acc += kk * Lf[b * 256 + s]; }
            u0[MLAT + tid] = (bf16_t)f2bf(acc / totc + dsk * uc);
            __syncthreads();
#undef tid
        }
    }
    GRID_BAR();
    if constexpr ((PH >> 5) & 1) {
        const Args& A = kargs_ref(); unsigned char* ws = A.ws; int tid_; asm volatile("v_mbcnt_lo_u32_b32 %0, -1, 0\n\tv_mbcnt_hi_u32_b32 %0, -1, %0" : "=v"(tid_)); tid_ += wave_s * 64; const int tid = tid_, lane = tid & 63, wave = __builtin_amdgcn_readfirstlane(tid >> 6), gw = bx * 8 + wave, NGW = G * 8; (void)lane; (void)gw; (void)NGW;
        LAS bf16_t* T = (LAS bf16_t*)lds;
        for (int it = bx; it < NSTRIP * 32; it += G) {
            const int r0 = (it >> 5) * 64, c0 = (it & 31) * 64;
            { const int chn = tid >> 3, rc = tid & 7; const u32x4 q = *(const u32x4*)(UT + (size_t)(c0 + chn) * MALL + r0 + 8 * rc);
#pragma unroll
              for (int e = 0; e < 4; ++e) { T[(8 * rc + 2 * e) * 68 + chn] = (bf16_t)(q[e] & 0xffffu); T[(8 * rc + 2 * e + 1) * 68 + chn] = (bf16_t)(q[e] >> 16); } }
            __syncthreads();
            { const int row = tid >> 3, cc = tid & 7; bf16_t* gp = GB + (size_t)(r0 + row) * 2048 + c0 + 8 * cc; const u32x4 gq = *(const u32x4*)gp; u32x4 o;
#pragma unroll
              for (int e = 0; e < 4; ++e) { const float y0 = bf2f(T[row * 68 + 8 * cc + 2 * e]), y1 = bf2f(T[row * 68 + 8 * cc + 2 * e + 1]);
                  o[e] = pk2(y0 * bf2f((bf16_t)(gq[e] & 0xffffu)), y1 * bf2f((bf16_t)(gq[e] >> 16))); }
              *(u32x4*)gp = o; }
            __syncthreads();
        }
    }
    GRID_BAR();
    if constexpr ((PH >> 6) & 1) {
        const Args& A = kargs_ref(); unsigned char* ws = A.ws; int tid_; asm volatile("v_mbcnt_lo_u32_b32 %0, -1, 0\n\tv_mbcnt_hi_u32_b32 %0, -1, %0" : "=v"(tid_)); tid_ += wave_s * 64; const int tid = tid_, lane = tid & 63, wave = __builtin_amdgcn_readfirstlane(tid >> 6), gw = bx * 8 + wave, NGW = G * 8; (void)lane; (void)gw; (void)NGW;
        pg8::Gemm g{GB, WOUT, MALL, 1024, 2048}; pg8::StaticOrder So; So.init(MALL, 1024, G, bx);
        pg8::EpiRes E{A.x, A.ctx, A.out, X1C, MOD};
        pg8::gemm_phase<pg8::EpiRes, pg8::StaticOrder, true, true>(lds, g, So, E, tid_);
    }
    GRID_BAR();
    if constexpr ((PH >> 7) & 1) {
        const Args& A = kargs_ref(); unsigned char* ws = A.ws; int tid_; asm volatile("v_mbcnt_lo_u32_b32 %0, -1, 0\n\tv_mbcnt_hi_u32_b32 %0, -1, %0" : "=v"(tid_)); tid_ += wave_s * 64; const int tid = tid_, lane = tid & 63, wave = __builtin_amdgcn_readfirstlane(tid >> 6), gw = bx * 8 + wave, NGW = G * 8; (void)lane; (void)gw; (void)NGW;
        for (int m = gw; m < MALL; m += NGW) { const int src = m < LSEQ ? 0 : (m < MLAT ? 1 : 2);
            const float* xr = m < MLAT ? A.out + (size_t)m * DM : X1C + (size_t)(m - MLAT) * DM;
            norm_row(xr, A.norm_g + DM, MOD + (3 + src) * 3072, H + (size_t)m * DM, lane); }
    }
    GRID_BAR();
    if constexpr ((PH >> 8) & 1) {
        const Args& A = kargs_ref(); unsigned char* ws = A.ws; int tid_; asm volatile("v_mbcnt_lo_u32_b32 %0, -1, 0\n\tv_mbcnt_hi_u32_b32 %0, -1, %0" : "=v"(tid_)); tid_ += wave_s * 64; const int tid = tid_, lane = tid & 63, wave = __builtin_amdgcn_readfirstlane(tid >> 6), gw = bx * 8 + wave, NGW = G * 8; (void)lane; (void)gw; (void)NGW;
        pg8::Gemm g{H, AWIN, MALL, 5120, 1024}; pg8::StaticOrder So; So.init(MALL, 5120, G, bx);
        pg8::EpiQKV E{A.at_q_g, A.at_k_g, ROPE, Q, KB, VB, ZS, (LAS float*)(lds + LDS_XCH)};
        pg8::gemm_phase<pg8::EpiQKV, pg8::StaticOrder, true, true>(lds, g, So, E, tid_);
    }
    GRID_BAR();
    if constexpr ((PH >> 9) & 1) {
        const Args& A = kargs_ref(); unsigned char* ws = A.ws; int tid_; asm volatile("v_mbcnt_lo_u32_b32 %0, -1, 0\n\tv_mbcnt_hi_u32_b32 %0, -1, %0" : "=v"(tid_)); tid_ += wave_s * 64; const int tid = tid_, lane = tid & 63, wave = __builtin_amdgcn_readfirstlane(tid >> 6), gw = bx * 8 + wave, NGW = G * 8; (void)lane; (void)gw; (void)NGW;
        for (int un = bx; un < NB * 16 * 32; un += G) {
            const int qb = un & 31, gq = (un >> 5) & 3, kvh = (un >> 7) & 3, b = un >> 9, h = kvh * 4 + gq;
            const size_t qoff = ((size_t)(b * LSEQ + qb * 256)) * 2048 + h * 128, koff = ((size_t)(b * 4 + kvh) * SKV) * 128;
            int t2; asm volatile("v_mbcnt_lo_u32_b32 %0, -1, 0\n\tv_mbcnt_hi_u32_b32 %0, -1, %0" : "=v"(t2)); t2 += wave_s * 64;
            att::attn_dense_body<att::bf16>(Q + qoff, KB + koff, VB + koff, ZS + qoff, SKV, (char*)lds_raw, t2);
        }
    }
    GRID_BAR();
    if constexpr ((PH >> 10) & 1) {
        const Args& A = kargs_ref(); unsigned char* ws = A.ws; int tid_; asm volatile("v_mbcnt_lo_u32_b32 %0, -1, 0\n\tv_mbcnt_hi_u32_b32 %0, -1, %0" : "=v"(tid_)); tid_ += wave_s * 64; const int tid = tid_, lane = tid & 63, wave = __builtin_amdgcn_readfirstlane(tid >> 6), gw = bx * 8 + wave, NGW = G * 8; (void)lane; (void)gw; (void)NGW;
        pg8::Gemm g{ZS, AWOUT, MLAT, 1024, 2048}; pg8::StaticOrder So; So.init(MLAT, 1024, G, bx);
        pg8::EpiRes E{A.out, A.out, A.out, A.out, MOD + 3 * 3072};
        pg8::gemm_phase<pg8::EpiRes, pg8::StaticOrder, true, true>(lds, g, So, E, tid_);
    }
}

extern "C" void kernel_launch(void* const* d_in, const int* in_sizes, int n_in, void* d_out, int out_size, void* d_ws, size_t ws_size, hipStream_t stream) {
    static int grid = 0;
    if (grid == 0) {
        if (n_in != 24 || out_size != MLAT * DM || ws_size < WS_END) { fprintf(stderr, "kernel_launch: unexpected shapes (n_in %d out %d ws %zu)\n", n_in, out_size, ws_size); grid = -1; return; }
        int dev = 0, cus = 0, per_cu = 0;
        (void)hipGetDevice(&dev); (void)hipDeviceGetAttribute(&cus, hipDeviceAttributeMultiprocessorCount, dev);
        if (hipFuncSetAttribute((const void*)mk_fwd, hipFuncAttributeMaxDynamicSharedMemorySize, LDS_BYTES) != hipSuccess) { fprintf(stderr, "kernel_launch: hipFuncSetAttribute failed\n"); grid = -1; return; }
        if (hipOccupancyMaxActiveBlocksPerMultiprocessor(&per_cu, (const void*)mk_fwd, NTHR, LDS_BYTES) != hipSuccess || per_cu < 1) { fprintf(stderr, "kernel_launch: occupancy query says %d\n", per_cu); per_cu = 1; }
        (void)hipGetLastError();
        grid = cus;
    }
    if (grid < 0) return;
    if (hipMemsetAsync((char*)d_ws + WS_CTL, 0, CTL_ZERO_BYTES, stream) != hipSuccess) { fprintf(stderr, "kernel_launch: memset failed\n"); return; }
    Args a{};
    const float** p = (const float**)&a;
    for (int i = 0; i < 24; ++i) p[i] = (const float*)d_in[i];
    a.out = (float*)d_out; a.ws = (unsigned char*)d_ws;
    void* args[] = {&a};
    hipError_t e = hipLaunchCooperativeKernel((const void*)mk_fwd, dim3(grid), dim3(NTHR), args, LDS_BYTES, stream);
    if (e != hipSuccess) fprintf(stderr, "cooperative launch failed: %s (grid %d)\n", hipGetErrorString(e), grid);
}
```

```cpp
#include <hip/hip_runtime.h>
#include <hip/hip_cooperative_groups.h>
#include <cstdio>
#include <cstdint>
namespace cg = cooperative_groups;

#define LAS __attribute__((address_space(3)))
typedef unsigned short bf16_t;
typedef float f32x4 __attribute__((ext_vector_type(4)));
typedef unsigned u32x4 __attribute__((ext_vector_type(4)));
typedef unsigned u32x2 __attribute__((ext_vector_type(2)));

constexpr int DM = 1024, LSEQ = 8192, NB = 2, CTX = 256, EH = 2048;
constexpr int MLAT = NB * LSEQ, MALL = MLAT + NB * CTX;
constexpr int SKV = LSEQ + CTX;
constexpr int NSTRIP = MALL / 64;
constexpr float MAX_DECAY = -15.350567286626973f, MIN_DECAY = -3.0701134573253945f;
constexpr float EPSN = 1e-6f;
constexpr int NTHR = 512;

constexpr size_t MiB = 1u << 20;
constexpr size_t WS_CTL = 0, CTL_ZERO_BYTES = 16384;
constexpr size_t WS_MOD = 1 * MiB;
constexpr size_t WS_H3 = 2 * MiB;
constexpr size_t WS_H3C = 4 * MiB;
constexpr size_t WS_ROPE = 5 * MiB;
constexpr size_t WS_KTC = 6 * MiB;
constexpr size_t WS_X1C = 10 * MiB;
constexpr size_t WS_WIN = 12 * MiB;
constexpr size_t WS_WOUT = 28 * MiB;
constexpr size_t WS_AWIN = 32 * MiB;
constexpr size_t WS_AWOUT = 42 * MiB;
constexpr size_t WS_H = 46 * MiB;
constexpr size_t WS_S = 79 * MiB;
constexpr size_t WS_UT = 112 * MiB;
constexpr size_t WS_G = 178 * MiB;
constexpr size_t WS_Q = 112 * MiB;
constexpr size_t WS_ZS = 176 * MiB;
constexpr size_t WS_KB = 79 * MiB;
constexpr size_t WS_VB = WS_KB + (size_t)NB * 4 * SKV * 128 * 2;
constexpr size_t WS_H3X = 244 * MiB;
constexpr size_t WS_W4X = 249 * MiB;
constexpr size_t WS_END = 252 * MiB;
static_assert(WS_VB + (size_t)NB * 4 * SKV * 128 * 2 <= WS_Q, "kv map");
static_assert(WS_ZS + (size_t)MLAT * 2048 * 2 <= WS_END, "zs map");

constexpr int LDS_BYTES = 163840;
constexpr int LDS_XCH = 131072;
constexpr int LDS_MISC = LDS_BYTES - 64;

__device__ __forceinline__ unsigned pk2(float lo, float hi) { unsigned r; asm("v_cvt_pk_bf16_f32 %0, %1, %2" : "=v"(r) : "v"(lo), "v"(hi)); return r; }
__device__ __forceinline__ unsigned f2bf(float f) { return pk2(f, f) & 0xffffu; }
__device__ __forceinline__ float bf2f(unsigned short h) { return __builtin_bit_cast(float, (unsigned)h << 16); }
__device__ __forceinline__ float silu_f(float z) { return z * __builtin_amdgcn_rcpf(1.f + __builtin_amdgcn_exp2f(-1.4426950408889634f * z)); }
__device__ __forceinline__ float wave_sum(float v) {
#pragma unroll
    for (int o = 1; o < 64; o <<= 1) v += __shfl_xor(v, o);
    return v;
}
namespace pg8 {
#define PG8_LAS __attribute__((address_space(3)))
typedef short bf16x8 __attribute__((ext_vector_type(8)));
constexpr int BM = 256, BK = 64, HALF = 128, HTB = HALF * BK * 2  , STAGE_BYTES = 8 * HTB, NXCD = 8, WGM = 8;

__host__ __device__ __forceinline__ int lds_byte(int r, int c) { const int st = (r >> 4) * 2 + (c >> 5), rr = r & 15, cc = c & 31, ob = rr * 64 + cc * 2; return st * 1024 + (ob ^ (((ob >> 9) & 1) << 5)); }
__host__ __device__ __forceinline__ void stage_rc(int b, int& R, int& C) { const int st = b / 1024, sb = b % 1024, swz = sb ^ (((sb >> 9) & 1) << 5); R = (st >> 1) * 16 + swz / 64; C = (st & 1) * 32 + (swz % 64) / 2; }
__host__ __device__ __forceinline__ int perm32(int rho) { const int n = rho >> 4, i = rho & 15; return 8 * (i >> 2) + 4 * n + (i & 3); }

struct Unit { int pm, pn, k0, nt; };
struct Gemm { const bf16_t* A; const bf16_t* Bt; int M, N, K; };
struct StaticOrder {
    int nM, nN, nwg, G, c, knt;
    __host__ __device__ void init(int M, int N, int G_, int c_, int K_) { nM = M / BM; nN = N / BM; nwg = nM * nN; G = G_; c = c_; knt = K_ / BK; }
    __host__ __device__ bool next(int i, Unit& u) const {
        const long L = (long)i * G + c; if (L >= nwg) return false;
        int wgid = (int)L; { const int q = nwg / NXCD, r = nwg % NXCD, xcd = wgid % NXCD, off = wgid / NXCD; wgid = (xcd < r ? xcd * (q + 1) : r * (q + 1) + (xcd - r) * q) + off; }
        const int nig = WGM * nN, gid = wgid / nig, fm = gid * WGM, gsz = (nM - fm) < WGM ? (nM - fm) : WGM;
        u.pm = fm + ((wgid % nig) % gsz); u.pn = (wgid % nig) / gsz; u.k0 = 0; u.nt = knt; return true;
    }
    __device__ __forceinline__ void a_ready(const Unit&) const {}
    __device__ __forceinline__ void done(const Unit&) const {}
};
__device__ __forceinline__ unsigned cvt_pk_bf16(float lo, float hi) { unsigned r; asm volatile("v_cvt_pk_bf16_f32 %0, %1, %2" : "=v"(r) : "v"(lo), "v"(hi)); return r; }
typedef float f32x2 __attribute__((ext_vector_type(2)));
__device__ __forceinline__ float dpp_ror1(float v) { return __builtin_bit_cast(float, __builtin_amdgcn_update_dpp(0, __builtin_bit_cast(int, v), 0x121, 0xf, 0xf, false)); }
__device__ __forceinline__ float dpp_ror15(float v) { return __builtin_bit_cast(float, __builtin_amdgcn_update_dpp(0, __builtin_bit_cast(int, v), 0x12f, 0xf, 0xf, false)); }
struct EpiHy {
    static constexpr bool PERM = true, AFTER_DRAIN = false;
    const float* cw; const float* cb; bf16_t* UT; bf16_t* G; float* S; PG8_LAS unsigned char* xl;
    __device__ __forceinline__ void operator()(const f32x4 (&acc)[2][2][4][2], const Unit& u, int wr, int wc, int fr, int fq) const {
        asm volatile("" : "+v"(fr), "+v"(fq));
        const int lane = fq * 16 + fr;
        const int c0 = u.pn * 64 + 16 * wc + 4 * fq;
        PG8_LAS unsigned char* T = xl + (wr * 4 + wc) * 4096;
        f32x4 w[3][3], bb[3];
#pragma unroll
        for (int s = 0; s < 3; ++s) { bb[s] = *(const f32x4*)(cb + s * 2048 + c0);
#pragma unroll
            for (int t = 0; t < 3; ++t) w[s][t] = *(const f32x4*)(cw + t * 6144 + s * 2048 + c0); }
#pragma unroll
        for (int ai = 0; ai < 2; ++ai) {
            const int strip = u.pm * 4 + ai * 2 + wr;
#pragma unroll
            for (int m = 0; m < 4; ++m) {
                f32x4 cv[3];
#pragma unroll
                for (int s = 0; s < 3; ++s) {
                    const f32x4 cur = acc[ai][s >> 1][m][s & 1];
                    const f32x4 up = acc[ai][s >> 1][m > 0 ? m - 1 : 0][s & 1];
                    const f32x4 dn = acc[ai][s >> 1][m < 3 ? m + 1 : 3][s & 1];
                    f32x4 pv, nx;
#pragma unroll
                    for (int j = 0; j < 4; ++j) { const float sp = (fr == 15) ? up[j] : cur[j], sn = (fr == 0) ? dn[j] : cur[j]; pv[j] = dpp_ror1(sp); nx[j] = dpp_ror15(sn); }
                    cv[s] = w[s][0] * pv + w[s][1] * cur + w[s][2] * nx + bb[s];
                }
                const f32x4 z = acc[ai][1][m][1];
                const int row = strip * 64 + 16 * m + fr;
                const f32x4 uu = cv[1] * cv[2];
                f32x4 g;
#pragma unroll
                for (int j = 0; j < 4; ++j) { g[j] = cv[0][j] * silu_f(z[j]); *(PG8_LAS bf16_t*)(T + (4 * fq + j) * 144 + (16 * m + fr) * 2) = (bf16_t)f2bf(uu[j]); }
                u32x2 gw; gw.x = pk2(g[0], g[1]); gw.y = pk2(g[2], g[3]);
                *(u32x2*)(G + (size_t)row * 2048 + c0) = gw;
                __builtin_amdgcn_sched_barrier(0);
            }
            {
                const int chn = lane >> 2, chunk = lane & 3;
                const u32x4 q0 = *(const PG8_LAS u32x4*)(T + chn * 144 + chunk * 32), q1 = *(const PG8_LAS u32x4*)(T + chn * 144 + chunk * 32 + 16);
                bf16_t* up_ = UT + (size_t)(u.pn * 64 + 16 * wc + chn) * MALL + strip * 64 + 16 * chunk;
                *(u32x4*)up_ = q0; *(u32x4*)(up_ + 8) = q1;
            }
            if (fr < 2) {
#pragma unroll
                for (int s = 0; s < 4; ++s) *(f32x4*)(S + ((size_t)((strip * 4 + fr) * 4 + s)) * 2048 + c0) = acc[ai][s >> 1][0][s & 1];
            }
            if (fr >= 14) {
#pragma unroll
                for (int s = 0; s < 4; ++s) *(f32x4*)(S + ((size_t)((strip * 4 + fr - 12) * 4 + s)) * 2048 + c0) = acc[ai][s >> 1][3][s & 1];
            }
        }
    }
};
struct EpiRes {
    static constexpr bool PERM = true, AFTER_DRAIN = false;
    const float* xlat; const float* xctx; float* olat; float* octx; const float* mod;
    __device__ __forceinline__ void operator()(const f32x4 (&acc)[2][2][4][2], const Unit& u, int wr, int wc, int fr, int fq) const {
        asm volatile("" : "+v"(fr), "+v"(fq));
        const int col0 = u.pn * 256 + wc * 32 + 8 * fq;
#pragma unroll
        for (int ai = 0; ai < 2; ++ai)
#pragma unroll
            for (int m = 0; m < 4; ++m) {
                const int row = u.pm * 256 + ai * 128 + wr * 64 + m * 16 + fr;
                const int src = row < LSEQ ? 0 : (row < MLAT ? 1 : 2);
                const float* xi; float* od;
                if (row < MLAT) { xi = xlat + (size_t)row * DM; od = olat + (size_t)row * DM; } else { xi = xctx + (size_t)(row - MLAT) * DM; od = octx + (size_t)(row - MLAT) * DM; }
                const float* gt = mod + src * 3072 + 2048;
#pragma unroll
                for (int bj = 0; bj < 2; ++bj) { const int col = col0 + bj * 128;
                    const f32x4 g0 = *(const f32x4*)(gt + col), g1 = *(const f32x4*)(gt + col + 4), x0 = *(const f32x4*)(xi + col), x1 = *(const f32x4*)(xi + col + 4);
                    *(f32x4*)(od + col) = x0 + g0 * acc[ai][bj][m][0]; *(f32x4*)(od + col + 4) = x1 + g1 * acc[ai][bj][m][1]; }
            }
    }
};
struct EpiQKV {
    static constexpr bool PERM = true, AFTER_DRAIN = false;
    const float* qg; const float* kg; const float* rope; bf16_t* Q; bf16_t* KB; bf16_t* VB; bf16_t* ZS; PG8_LAS float* xl;
    __device__ __forceinline__ void operator()(const f32x4 (&acc)[2][2][4][2], const Unit& u, int wr, int wc, int fr, int fq) const {
        asm volatile("" : "+v"(fr), "+v"(fq));
        const int pn = u.pn;
        if (pn < 10) {
            const bool isq = pn < 8;
#pragma unroll
            for (int ai = 0; ai < 2; ++ai)
#pragma unroll
                for (int m = 0; m < 4; ++m)
#pragma unroll
                    for (int bj = 0; bj < 2; ++bj) { const f32x4 a = acc[ai][bj][m][0], b = acc[ai][bj][m][1];
                        float s = (a[0] * a[0] + a[1] * a[1]) + (a[2] * a[2] + a[3] * a[3]) + (b[0] * b[0] + b[1] * b[1]) + (b[2] * b[2] + b[3] * b[3]);
                        s += __shfl_xor(s, 16); s += __shfl_xor(s, 32);
                        if (fq == 0) xl[((ai * 128 + wr * 64 + m * 16 + fr) * 2 + bj) * 4 + wc] = s; }
            asm volatile("s_waitcnt lgkmcnt(0)" ::: "memory"); __builtin_amdgcn_s_barrier(); asm volatile("" ::: "memory");
            const float* gg = isq ? qg : kg; const int d0 = 2 * (4 * wc + fq);
            float gv[2][4];
#pragma unroll
            for (int n = 0; n < 2; ++n)
#pragma unroll
                for (int j = 0; j < 4; ++j) gv[n][j] = gg[32 * (2 * n + (j >> 1)) + d0 + (j & 1)] * (isq ? 0.088388347648318440f * 1.4426950408889634f : 1.0f);
#pragma unroll
            for (int ai = 0; ai < 2; ++ai)
#pragma unroll
                for (int m = 0; m < 4; ++m) {
                    const int rl = ai * 128 + wr * 64 + m * 16 + fr, row = u.pm * 256 + rl;
                    const bool lat = row < MLAT; const int t = row & (LSEQ - 1);
                    const f32x4 rr = *(const f32x4*)(rope + ((t >> 6) * 32 + d0) * 2);
                    const f32x4 rc = *(const f32x4*)(rope + ((t & 63) * 32 + d0) * 2);
                    int bb_, ss_; if (lat) { bb_ = row >> 13; ss_ = t; } else { bb_ = (row - MLAT) >> 8; ss_ = LSEQ + ((row - MLAT) & 255); }
#pragma unroll
                    for (int bj = 0; bj < 2; ++bj) {
                        const f32x4 p4 = *(const PG8_LAS f32x4*)(xl + (rl * 2 + bj) * 4);
                        const float rinv = rsqrtf(((p4[0] + p4[1]) + (p4[2] + p4[3])) * (1.f / 128.f) + EPSN);
                        float y[2][4], o[2][4];
#pragma unroll
                        for (int n = 0; n < 2; ++n)
#pragma unroll
                            for (int j = 0; j < 4; ++j) y[n][j] = acc[ai][bj][m][n][j] * rinv * gv[n][j];
                        if (lat) {
#pragma unroll
                            for (int e = 0; e < 2; ++e) {
                                o[0][e] = y[0][e] * rr[2 * e] - y[0][2 + e] * rr[2 * e + 1]; o[0][2 + e] = y[0][e] * rr[2 * e + 1] + y[0][2 + e] * rr[2 * e];
                                o[1][e] = y[1][e] * rc[2 * e] - y[1][2 + e] * rc[2 * e + 1]; o[1][2 + e] = y[1][e] * rc[2 * e + 1] + y[1][2 + e] * rc[2 * e]; }
                        } else {
#pragma unroll
                            for (int n = 0; n < 2; ++n)
#pragma unroll
                                for (int j = 0; j < 4; ++j) o[n][j] = y[n][j];
                        }
                        u32x4 wv; wv.x = pk2(o[0][0], o[0][1]); wv.y = pk2(o[0][2], o[0][3]); wv.z = pk2(o[1][0], o[1][1]); wv.w = pk2(o[1][2], o[1][3]);
                        if (isq) { if (lat) *(u32x4*)(Q + (size_t)row * 2048 + (2 * pn + bj) * 128 + 32 * wc + 8 * fq) = wv; }
                        else { const int kvh = 2 * (pn - 8) + bj; *(u32x4*)(KB + ((size_t)(bb_ * 4 + kvh) * SKV + ss_) * 128 + 32 * wc + 8 * fq) = wv; }
                        __builtin_amdgcn_sched_barrier(0);
                    }
                }
        } else {
#pragma unroll
            for (int ai = 0; ai < 2; ++ai)
#pragma unroll
                for (int m = 0; m < 4; ++m) {
                    const int row = u.pm * 256 + ai * 128 + wr * 64 + m * 16 + fr;
                    const bool lat = row < MLAT; const int t = row & (LSEQ - 1);
                    int bb_, ss_; if (lat) { bb_ = row >> 13; ss_ = t; } else { bb_ = (row - MLAT) >> 8; ss_ = LSEQ + ((row - MLAT) & 255); }
#pragma unroll
                    for (int bj = 0; bj < 2; ++bj) {
                        f32x4 a = acc[ai][bj][m][0], b = acc[ai][bj][m][1];
                        if (pn < 12) {
                            u32x4 wv; wv.x = pk2(a[0], a[1]); wv.y = pk2(a[2], a[3]); wv.z = pk2(b[0], b[1]); wv.w = pk2(b[2], b[3]);
                            const int kvh = 2 * (pn - 10) + bj; *(u32x4*)(VB + ((size_t)(bb_ * 4 + kvh) * SKV + ss_) * 128 + 32 * wc + 8 * fq) = wv;
                        } else if (lat) {
#pragma unroll
                            for (int j = 0; j < 4; ++j) { a[j] = silu_f(a[j]); b[j] = silu_f(b[j]); }
                            u32x4 wv; wv.x = pk2(a[0], a[1]); wv.y = pk2(a[2], a[3]); wv.z = pk2(b[0], b[1]); wv.w = pk2(b[2], b[3]);
                            *(u32x4*)(ZS + (size_t)row * 2048 + (pn - 12) * 256 + bj * 128 + 32 * wc + 8 * fq) = wv;
                        }
                    }
                }
        }
    }
};

struct EpiKgen {
    static constexpr bool PERM = true, AFTER_DRAIN = false;
    bf16_t* KT; float* KTC;
    __device__ __forceinline__ void operator()(const f32x4 (&acc)[2][2][4][2], const Unit& u, int wr, int wc, int fr, int fq) const {
        asm volatile("" : "+v"(fr), "+v"(fq));
#pragma unroll
        for (int ai = 0; ai < 2; ++ai)
#pragma unroll
            for (int m = 0; m < 4; ++m) {
                const int n = u.pm * 256 + ai * 128 + wr * 64 + m * 16 + fr, dir = n >> 11, ch = n & 2047;
                const float delta = fabsf(MIN_DECAY + (float)ch * ((MAX_DECAY - MIN_DECAY) / 2047.0f));
#pragma unroll
                for (int bj = 0; bj < 2; ++bj) {
                    const int t0 = u.pn * 256 + bj * 128 + wc * 32 + 8 * fq;
                    const bool lat = u.pn < 32; const int tb = lat ? t0 : t0 - LSEQ; const float rl = lat ? (1.0f / 8191.0f) : (1.0f / 255.0f);
                    float v[8];
#pragma unroll
                    for (int e = 0; e < 8; ++e) v[e] = acc[ai][bj][m][e >> 2][e & 3] * __expf(-(float)(tb + e) * rl * delta);
                    if (lat) { u32x4 w; w.x = pk2(v[0], v[1]); w.y = pk2(v[2], v[3]); w.z = pk2(v[4], v[5]); w.w = pk2(v[6], v[7]); *(u32x4*)(KT + (size_t)(ch * 2 + dir) * LSEQ + tb) = w; }
                    else { float* kp = KTC + (size_t)(ch * 2 + dir) * 256 + tb; *(f32x4*)kp = (f32x4){v[0], v[1], v[2], v[3]}; *(f32x4*)(kp + 4) = (f32x4){v[4], v[5], v[6], v[7]}; }
                }
            }
    }
};

struct OrderP6 {
    StaticOrder so; int c;
    __host__ __device__ void init(int G_, int c_) { so.init(MLAT, 1024, G_, c_, 2048); c = c_; }
    __host__ __device__ bool next(int i, Unit& u) const {
        const int G = so.G, nl = c < 256 ? (256 - c + G - 1) / G : 0;
        if (i < nl) return so.next(i, u);
        const int s = (i - nl) * G + c;
        if (s < 64) { u.pm = 64 + (s >> 5); u.pn = (s >> 3) & 3; u.k0 = (s & 7) * 256; u.nt = 4; return true; }
        return false;
    }
    __device__ __forceinline__ void a_ready(const Unit&) const {}
    __device__ __forceinline__ void done(const Unit&) const {}
};
struct EpiRes6 {
    static constexpr bool PERM = true, AFTER_DRAIN = false;
    const float* xlat; float* olat; const float* mod; float* PART;
    __device__ __forceinline__ void operator()(const f32x4 (&acc)[2][2][4][2], const Unit& u, int wr, int wc, int fr, int fq) const {
        asm volatile("" : "+v"(fr), "+v"(fq));
        const int col0 = u.pn * 256 + wc * 32 + 8 * fq;
#pragma unroll
        for (int ai = 0; ai < 2; ++ai)
#pragma unroll
            for (int m = 0; m < 4; ++m) {
                const int row = u.pm * 256 + ai * 128 + wr * 64 + m * 16 + fr;
                if (u.pm < 64) {
                    const float* xi = xlat + (size_t)row * DM; float* od = olat + (size_t)row * DM; const float* gt = mod + (row < LSEQ ? 0 : 1) * 3072 + 2048;
#pragma unroll
                    for (int bj = 0; bj < 2; ++bj) { const int col = col0 + bj * 128;
                        const f32x4 g0 = *(const f32x4*)(gt + col), g1 = *(const f32x4*)(gt + col + 4), x0 = *(const f32x4*)(xi + col), x1 = *(const f32x4*)(xi + col + 4);
                        *(f32x4*)(od + col) = x0 + g0 * acc[ai][bj][m][0]; *(f32x4*)(od + col + 4) = x1 + g1 * acc[ai][bj][m][1]; }
                } else {
                    float* pp = PART + ((size_t)(u.k0 >> 8) * 512 + (row - MLAT)) * DM;
#pragma unroll
                    for (int bj = 0; bj < 2; ++bj) { const int col = col0 + bj * 128; *(f32x4*)(pp + col) = acc[ai][bj][m][0]; *(f32x4*)(pp + col + 4) = acc[ai][bj][m][1]; }
                }
            }
    }
};
template <class Epi, class Sched, bool ALIGN_EPI = false, bool SP2 = false>
__device__ __forceinline__ void gemm_phase(PG8_LAS unsigned char* lds, const Gemm g, const Sched& S, const Epi& E, int tid_) {
    asm volatile("" : "+v"(tid_));
    const int tid = tid_, wid = __builtin_amdgcn_readfirstlane(tid >> 6), lane = tid & 63, wr = wid >> 2, wc = wid & 3, fr = lane & 15, fq = lane >> 4;
    const int K = g.K;
    unsigned voffA[2], voffB[2];
#pragma unroll
    for (int i = 0; i < 2; ++i) { int R, C; stage_rc(tid * 16 + i * 8192, R, C); const int Rb = Epi::PERM ? ((R & ~31) + perm32(R & 31)) : R;
        voffA[i] = (unsigned)(R * K + C) * 2u; voffB[i] = (unsigned)(Rb * K + C) * 2u; }
    const size_t kstep = (size_t)(BK * 2);
    const size_t hstep = (size_t)HALF * K * 2;
    const size_t tstep = 2 * hstep;
    const unsigned ldsw = (unsigned)wid * 1024u;
    const int aoff = lds_byte(wr * 64 + fr, fq * 8), boff = lds_byte(wc * 32 + fr, fq * 8);
#define PG8_SA(b, h) (((b) * 2 + (h)) * HTB)
#define PG8_SB(b, h) ((4 + (b) * 2 + (h)) * HTB)
#define PG8_STAGE(bufoff, gbase, voff) do { _Pragma("unroll") for (int _i = 0; _i < 2; ++_i) \
        __builtin_amdgcn_global_load_lds((const unsigned*)((const char*)(gbase) + (voff)[_i]), (PG8_LAS unsigned*)(lds + (bufoff) + ldsw + _i * 8192), 16, 0, 0); } while (0)
#define PG8_LDA(dst, b, h) do { _Pragma("unroll") for (int m = 0; m < 4; ++m) _Pragma("unroll") for (int k = 0; k < 2; ++k) dst[m][k] = *(const PG8_LAS bf16x8*)(lds + PG8_SA(b, h) + aoff + m * 2048 + k * 1024); } while (0)
#define PG8_LDB(dst, b, h) do { _Pragma("unroll") for (int n = 0; n < 2; ++n) _Pragma("unroll") for (int k = 0; k < 2; ++k) dst[n][k] = *(const PG8_LAS bf16x8*)(lds + PG8_SB(b, h) + boff + n * 2048 + k * 1024); } while (0)
#define PG8_MMA(ai, bj, At, Bt) do { __builtin_amdgcn_s_setprio(1); _Pragma("unroll") for (int m = 0; m < 4; ++m) _Pragma("unroll") for (int n = 0; n < 2; ++n) _Pragma("unroll") for (int k = 0; k < 2; ++k) \
        acc[ai][bj][m][n] = __builtin_amdgcn_mfma_f32_16x16x32_bf16(Bt[n][k], At[m][k], acc[ai][bj][m][n], 0, 0, 0); __builtin_amdgcn_s_setprio(0); } while (0)
#define PG8_WAIT_V(n) asm volatile("s_waitcnt vmcnt(" #n ")" ::: "memory")
#define PG8_WAIT_L(n) asm volatile("s_waitcnt lgkmcnt(" #n ")" ::: "memory")
#define PG8_BAR __builtin_amdgcn_s_barrier()
#define PG8_SCHED __builtin_amdgcn_sched_barrier(0)
    Unit cur, nxt; int ui = 0;
    if (!S.next(0, cur)) return;
    f32x4 acc[2][2][4][2];
#pragma unroll
    for (int a = 0; a < 2; ++a)
#pragma unroll
        for (int b = 0; b < 2; ++b)
#pragma unroll
            for (int m = 0; m < 4; ++m)
#pragma unroll
                for (int n = 0; n < 2; ++n) acc[a][b][m][n] = (f32x4){0.f, 0.f, 0.f, 0.f};
    bf16x8 At[4][2], B0[2][2], B1[2][2];
    const char* cA = (const char*)g.A + (size_t)cur.pm * tstep + (size_t)cur.k0 * 2; const char* cB = (const char*)g.Bt + (size_t)cur.pn * tstep + (size_t)cur.k0 * 2;
    S.a_ready(cur);
    if constexpr (SP2) {
        PG8_STAGE(PG8_SB(0, 0), cB, voffB); PG8_STAGE(PG8_SB(0, 1), cB + hstep, voffB); PG8_STAGE(PG8_SA(0, 0), cA, voffA); PG8_STAGE(PG8_SA(0, 1), cA + hstep, voffA);
        if (wr == 1) PG8_BAR;
        PG8_WAIT_V(2); PG8_BAR;
        PG8_STAGE(PG8_SB(1, 0), cB + kstep, voffB); PG8_STAGE(PG8_SA(1, 0), cA + kstep, voffA); PG8_STAGE(PG8_SB(1, 1), cB + hstep + kstep, voffB);
        PG8_WAIT_V(6); PG8_BAR;
    } else {
        PG8_STAGE(PG8_SB(0, 0), cB, voffB); PG8_STAGE(PG8_SA(0, 0), cA, voffA); PG8_STAGE(PG8_SB(0, 1), cB + hstep, voffB); PG8_STAGE(PG8_SA(0, 1), cA + hstep, voffA);
        if (wr == 1) PG8_BAR;
        PG8_WAIT_V(4); PG8_BAR;
        PG8_STAGE(PG8_SB(1, 0), cB + kstep, voffB); PG8_STAGE(PG8_SA(1, 0), cA + kstep, voffA); PG8_STAGE(PG8_SB(1, 1), cB + hstep + kstep, voffB);
        PG8_WAIT_V(6); PG8_BAR;
    }
    for (;;) {
        const bool has_next = S.next(ui + 1, nxt);
        const char* nA = has_next ? (const char*)g.A + (size_t)nxt.pm * tstep + (size_t)nxt.k0 * 2 : cA; const char* nB = has_next ? (const char*)g.Bt + (size_t)nxt.pn * tstep + (size_t)nxt.k0 * 2 : cB;
        const int nt = cur.nt;
        for (int t = 0; t < nt; t += 2) {
            const bool last = (t == nt - 2);
            const char* a1 = cA + (size_t)(t + 1) * kstep;
            const char* a2 = last ? nA : cA + (size_t)(t + 2) * kstep; const char* b2 = last ? nB : cB + (size_t)(t + 2) * kstep;
            const char* a3 = a2 + kstep; const char* b3 = b2 + kstep;
            if (last && has_next) S.a_ready(nxt);
            if constexpr (SP2) {
            PG8_LDB(B0, 0, 0); PG8_LDB(B1, 0, 1); PG8_SCHED; PG8_LDA(At, 0, 0); PG8_STAGE(PG8_SA(1, 1), a1 + hstep, voffA);
            PG8_WAIT_V(8); PG8_WAIT_L(0); PG8_BAR; PG8_MMA(0, 0, At, B0); PG8_MMA(0, 1, At, B1); PG8_BAR; PG8_SCHED;
            PG8_LDA(At, 0, 1); PG8_STAGE(PG8_SB(0, 0), b2, voffB); PG8_STAGE(PG8_SB(0, 1), b2 + hstep, voffB); PG8_STAGE(PG8_SA(0, 0), a2, voffA);
            PG8_WAIT_V(8); PG8_WAIT_L(0); PG8_BAR; PG8_MMA(1, 0, At, B0); PG8_MMA(1, 1, At, B1); PG8_BAR; PG8_SCHED;
            PG8_LDB(B0, 1, 0); PG8_LDB(B1, 1, 1); PG8_SCHED; PG8_LDA(At, 1, 0); PG8_STAGE(PG8_SA(0, 1), a2 + hstep, voffA);
            PG8_WAIT_V(8); PG8_WAIT_L(0); PG8_BAR; PG8_MMA(0, 0, At, B0); PG8_MMA(0, 1, At, B1); PG8_BAR; PG8_SCHED;
            PG8_LDA(At, 1, 1); PG8_STAGE(PG8_SB(1, 0), b3, voffB); PG8_STAGE(PG8_SB(1, 1), b3 + hstep, voffB); PG8_STAGE(PG8_SA(1, 0), a3, voffA);
            PG8_WAIT_V(8); PG8_WAIT_L(0); PG8_BAR; PG8_MMA(1, 0, At, B0); PG8_MMA(1, 1, At, B1); PG8_BAR; PG8_SCHED;
            } else {
            PG8_LDB(B0, 0, 0); PG8_SCHED; PG8_LDA(At, 0, 0); PG8_STAGE(PG8_SA(1, 1), a1 + hstep, voffA);
            PG8_WAIT_L(8); PG8_BAR; PG8_WAIT_L(0); PG8_MMA(0, 0, At, B0); PG8_BAR; PG8_SCHED;
            PG8_LDB(B1, 0, 1); PG8_STAGE(PG8_SB(0, 0), b2, voffB);
            PG8_BAR; PG8_WAIT_L(0); PG8_MMA(0, 1, At, B1); PG8_BAR;
            PG8_LDA(At, 0, 1); PG8_STAGE(PG8_SA(0, 0), a2, voffA);
            PG8_BAR; PG8_WAIT_L(0); PG8_MMA(1, 0, At, B0); PG8_BAR; PG8_SCHED;
            PG8_STAGE(PG8_SB(0, 1), b2 + hstep, voffB);
            PG8_WAIT_V(6); PG8_BAR; PG8_MMA(1, 1, At, B1); PG8_BAR;
            PG8_LDB(B0, 1, 0); PG8_SCHED; PG8_LDA(At, 1, 0); PG8_STAGE(PG8_SA(0, 1), a2 + hstep, voffA);
            PG8_WAIT_L(8); PG8_BAR; PG8_WAIT_L(0); PG8_MMA(0, 0, At, B0); PG8_BAR; PG8_SCHED;
            PG8_LDB(B1, 1, 1); PG8_STAGE(PG8_SB(1, 0), b3, voffB);
            PG8_BAR; PG8_WAIT_L(0); PG8_MMA(0, 1, At, B1); PG8_BAR;
            PG8_LDA(At, 1, 1); PG8_STAGE(PG8_SA(1, 0), a3, voffA);
            PG8_BAR; PG8_WAIT_L(0); PG8_MMA(1, 0, At, B0); PG8_BAR; PG8_SCHED;
            PG8_STAGE(PG8_SB(1, 1), b3 + hstep, voffB);
            PG8_WAIT_V(6); PG8_BAR; PG8_MMA(1, 1, At, B1); PG8_BAR;
            }
        }
        if constexpr (ALIGN_EPI) { if (wr == 0) PG8_BAR; }
        if constexpr (!Epi::AFTER_DRAIN) { E(acc, cur, wr, wc, fr, fq); S.done(cur); }
        if (!has_next) break;
#pragma unroll
        for (int a = 0; a < 2; ++a)
#pragma unroll
            for (int b = 0; b < 2; ++b)
#pragma unroll
                for (int m = 0; m < 4; ++m)
#pragma unroll
                    for (int n = 0; n < 2; ++n) acc[a][b][m][n] = (f32x4){0.f, 0.f, 0.f, 0.f};
        cur = nxt; cA = nA; cB = nB; ++ui;
        if constexpr (ALIGN_EPI) { if (wr == 1) PG8_BAR; }
    }
    PG8_WAIT_V(0);
    if constexpr (!ALIGN_EPI) { if (wr == 0) PG8_BAR; }
    PG8_BAR;
    if constexpr (Epi::AFTER_DRAIN) { E.fused(acc, cur, wr, wc, fr, fq, lds, wid, lane); S.done(cur); }
#undef PG8_SA
#undef PG8_SB
#undef PG8_STAGE
#undef PG8_LDA
#undef PG8_LDB
#undef PG8_MMA
#undef PG8_WAIT_V
#undef PG8_WAIT_L
#undef PG8_BAR
#undef PG8_SCHED
}
}
namespace att {
typedef unsigned short bf16;
constexpr int   D = 128, NW = 8, QBLK = 32, KVBLK = 64;
constexpr float SCALE = 0.088388347648318440f;
constexpr float THR = 8.f;
constexpr int SDEPTH = 2;
constexpr int LDQ = 2048, LDK = 128, LDO = 2048;
constexpr size_t SHM_V = KVBLK * D * 2, SHM_K = KVBLK * D * 2, SHM_ATTN = 3 * SHM_V + 3 * SHM_K + NW * 64 * 4;
using bf16x8 = __attribute__((ext_vector_type(8))) short;
using s16x4  = __attribute__((ext_vector_type(4))) short;
using f32x16 = __attribute__((ext_vector_type(16))) float;
using f32x8  = __attribute__((ext_vector_type(8))) float;
using u32x4  = __attribute__((ext_vector_type(4))) unsigned;
#define KSWZ(row, colB) ((row) * 256 + ((colB) ^ (((row) & 7) << 4)))
#define SBAR() __builtin_amdgcn_sched_barrier(0)
__device__ __forceinline__ int crow(int r, int hi) { return (r & 3) + 8 * (r >> 2) + 4 * hi; }
__device__ __forceinline__ unsigned cvtpk(float lo, float hi) {
  unsigned r; asm volatile("v_cvt_pk_bf16_f32 %0, %1, %2" : "=v"(r) : "v"(lo), "v"(hi)); return r;
}
template <typename TIn> struct Stage;
template <> struct Stage<bf16>  { using T = bf16x8;
  __device__ static __forceinline__ T ld8(const bf16* p) { return *reinterpret_cast<const bf16x8*>(p); }
  __device__ static __forceinline__ bf16x8 tobf(T x) { return x; } };
template <bool SHIFT> __device__ __forceinline__ void partialSMF(f32x16& p0, f32x16& p1, float mnC) {
  if (SHIFT) { for (int r = 0; r < 16; ++r) p0[r] += mnC; for (int r = 0; r < 16; ++r) p1[r] += mnC; }
  for (int r = 0; r < 16; ++r) p0[r] = __builtin_amdgcn_exp2f(p0[r]);
}
__device__ __forceinline__ void partialSM(f32x16& p0, f32x16& p1, float& m_reg, float& mn, float& alpha) {
  constexpr float C = SCALE * 1.4426950408889634f;
  float pmax = p0[0]; for (int r = 1; r < 16; ++r) pmax = fmaxf(pmax, p0[r]); for (int r = 0; r < 16; ++r) pmax = fmaxf(pmax, p1[r]);
  { auto rr = __builtin_amdgcn_permlane32_swap(__float_as_uint(pmax), __float_as_uint(pmax), false, false);
    pmax = fmaxf(__uint_as_float(rr[0]), __uint_as_float(rr[1])); }
  if (__builtin_expect(__all(pmax - m_reg <= THR / SCALE), 1)) { mn = m_reg; alpha = 1.f; }
  else { mn = fmaxf(m_reg, pmax); alpha = __builtin_amdgcn_exp2f((m_reg - mn) * C); m_reg = mn; }
  float mnC = -mn * C;
  for (int r = 0; r < 16; ++r) p0[r] = fmaf(p0[r], C, mnC); for (int r = 0; r < 16; ++r) p1[r] = fmaf(p1[r], C, mnC);
  for (int r = 0; r < 16; ++r) p0[r] = __builtin_amdgcn_exp2f(p0[r]);
}
__device__ __forceinline__ void finishSM(f32x16& p0, f32x16& p1, float alpha, float& l_reg, bf16x8& pa0, bf16x8& pa1, bf16x8& pa2, bf16x8& pa3) {
  for (int r = 0; r < 16; ++r) p1[r] = __builtin_amdgcn_exp2f(p1[r]);
  float ps = 0; for (int r = 0; r < 16; ++r) ps += p0[r]; for (int r = 0; r < 16; ++r) ps += p1[r];
  { auto rr = __builtin_amdgcn_permlane32_swap(__float_as_uint(ps), __float_as_uint(ps), false, false);
    ps = __uint_as_float(rr[0]) + __uint_as_float(rr[1]); }
  l_reg = l_reg * alpha + ps;
#define PK4(P, BASE, OUT) do { unsigned a0 = cvtpk(P[BASE + 0], P[BASE + 1]), a1 = cvtpk(P[BASE + 2], P[BASE + 3]);   \
    unsigned b0 = cvtpk(P[BASE + 4], P[BASE + 5]), b1 = cvtpk(P[BASE + 6], P[BASE + 7]);                              \
    auto r0 = __builtin_amdgcn_permlane32_swap(a0, b0, false, false); auto r1 = __builtin_amdgcn_permlane32_swap(a1, b1, false, false); \
    u32x4 w = {r0[0], r1[0], r0[1], r1[1]}; OUT = *reinterpret_cast<bf16x8*>(&w); } while (0)
  PK4(p0, 0, pa0); PK4(p0, 8, pa1); PK4(p1, 0, pa2); PK4(p1, 8, pa3);
#undef PK4
}
template <int OFF> __device__ __forceinline__ bf16x8 k_read(unsigned a) { bf16x8 r; asm volatile("ds_read_b128 %0, %1 offset:%2" : "=&v"(r) : "v"(a), "i"(OFF) : "memory"); return r; }
__device__ __forceinline__ void qkt(f32x16& p0, f32x16& p1, const bf16* Ks, const bf16x8* qr, int r32, int hi) {
  p0 = f32x16{}; p1 = f32x16{};
  const unsigned kb = (unsigned)(uintptr_t)Ks + (unsigned)r32 * 256u + (unsigned)((hi ^ (r32 & 1)) << 4), sw = (unsigned)(r32 >> 1) & 3u;
  const unsigned a0 = kb + ((0u ^ sw) << 5), a1 = kb + ((1u ^ sw) << 5), a2 = kb + ((2u ^ sw) << 5), a3 = kb + ((3u ^ sw) << 5);
  bf16x8 x0, y0, x1, y1;
#define KRD(X, Y, A, HI) do { X = k_read<(HI) * 128>(A); Y = k_read<(HI) * 128 + 8192>(A); } while (0)
#define KMM(X, Y, D0, N) do { asm volatile("s_waitcnt lgkmcnt(" #N ")" : "+v"(X), "+v"(Y) :: "memory");     \
    p0 = __builtin_amdgcn_mfma_f32_32x32x16_bf16(X, qr[D0], p0, 0, 0, 0); p1 = __builtin_amdgcn_mfma_f32_32x32x16_bf16(Y, qr[D0], p1, 0, 0, 0); } while (0)
  KRD(x0, y0, a0, 0); KRD(x1, y1, a1, 0);
  KMM(x0, y0, 0, 2); KRD(x0, y0, a2, 0);
  KMM(x1, y1, 1, 2); KRD(x1, y1, a3, 0);
  KMM(x0, y0, 2, 2); KRD(x0, y0, a0, 1);
  KMM(x1, y1, 3, 2); KRD(x1, y1, a1, 1);
  KMM(x0, y0, 4, 2); KRD(x0, y0, a2, 1);
  KMM(x1, y1, 5, 2); KRD(x1, y1, a3, 1);
  KMM(x0, y0, 6, 2);
  KMM(x1, y1, 7, 0);
#undef KRD
#undef KMM
}
__device__ __forceinline__ int v_st(int k, int c) { const int kk = (k & ~0xC) | ((k & 4) << 1) | ((k & 8) >> 1); return ((kk >> 3) * 4 + (c >> 5)) * 512 + ((kk & 7) * 32 + (c & 31)) * 2; }
__device__ __forceinline__ int v_rd_base(int lane) { return ((lane & 3) << 3) | (((lane >> 2) & 3) << 6) | (((lane >> 4) & 1) << 5) | (((lane >> 5) & 1) << 8); }
constexpr int v_rd_off(int d0, int ks, int half) { return d0 * 512 + ks * 4096 + half * 2048; }
template <int OFF> __device__ __forceinline__ s16x4 tr_read(int vb) {
  s16x4 r; asm volatile("ds_read_b64_tr_b16 %0, %1 offset:%2" : "=&v"(r) : "v"(vb), "i"(OFF) : "memory"); return r;
}
template <int D0> __device__ __forceinline__ void pv_one(f32x16& od, int vb, bf16x8 pa0, bf16x8 pa1, bf16x8 pa2, bf16x8 pa3) {
  const s16x4 l0 = tr_read<v_rd_off(D0, 0, 0)>(vb), h0 = tr_read<v_rd_off(D0, 0, 1)>(vb), l1 = tr_read<v_rd_off(D0, 1, 0)>(vb), h1 = tr_read<v_rd_off(D0, 1, 1)>(vb);
  const s16x4 l2 = tr_read<v_rd_off(D0, 2, 0)>(vb), h2 = tr_read<v_rd_off(D0, 2, 1)>(vb), l3 = tr_read<v_rd_off(D0, 3, 0)>(vb), h3 = tr_read<v_rd_off(D0, 3, 1)>(vb);
  asm volatile("s_waitcnt lgkmcnt(0)" ::: "memory"); SBAR();
#define PK(L, H) (bf16x8){L[0], L[1], L[2], L[3], H[0], H[1], H[2], H[3]}
  od = __builtin_amdgcn_mfma_f32_32x32x16_bf16(pa0, PK(l0, h0), od, 0, 0, 0);
  od = __builtin_amdgcn_mfma_f32_32x32x16_bf16(pa1, PK(l1, h1), od, 0, 0, 0);
  od = __builtin_amdgcn_mfma_f32_32x32x16_bf16(pa2, PK(l2, h2), od, 0, 0, 0);
  od = __builtin_amdgcn_mfma_f32_32x32x16_bf16(pa3, PK(l3, h3), od, 0, 0, 0);
#undef PK
}
struct VFrag { s16x4 l0, h0, l1, h1, l2, h2, l3, h3; };
template <int D0> __device__ __forceinline__ void vfrag_load(VFrag& f, int vb) {
  f.l0 = tr_read<v_rd_off(D0, 0, 0)>(vb); f.h0 = tr_read<v_rd_off(D0, 0, 1)>(vb); f.l1 = tr_read<v_rd_off(D0, 1, 0)>(vb); f.h1 = tr_read<v_rd_off(D0, 1, 1)>(vb);
  f.l2 = tr_read<v_rd_off(D0, 2, 0)>(vb); f.h2 = tr_read<v_rd_off(D0, 2, 1)>(vb); f.l3 = tr_read<v_rd_off(D0, 3, 0)>(vb); f.h3 = tr_read<v_rd_off(D0, 3, 1)>(vb);
}
__device__ __forceinline__ void vfrag_mma(f32x16& od, const VFrag& f, bf16x8 pa0, bf16x8 pa1, bf16x8 pa2, bf16x8 pa3) {
#define PK(L, H) (bf16x8){L[0], L[1], L[2], L[3], H[0], H[1], H[2], H[3]}
  od = __builtin_amdgcn_mfma_f32_32x32x16_bf16(pa0, PK(f.l0, f.h0), od, 0, 0, 0);
  od = __builtin_amdgcn_mfma_f32_32x32x16_bf16(pa1, PK(f.l1, f.h1), od, 0, 0, 0);
  od = __builtin_amdgcn_mfma_f32_32x32x16_bf16(pa2, PK(f.l2, f.h2), od, 0, 0, 0);
  od = __builtin_amdgcn_mfma_f32_32x32x16_bf16(pa3, PK(f.l3, f.h3), od, 0, 0, 0);
#undef PK
}
__device__ __forceinline__ void pv_d0(f32x16* o, int vb, bf16x8 pa0, bf16x8 pa1, bf16x8 pa2, bf16x8 pa3) {
  VFrag a, b;
  vfrag_load<0>(a, vb); vfrag_load<1>(b, vb);
  asm volatile("s_waitcnt lgkmcnt(8)" ::: "memory"); SBAR(); vfrag_mma(o[0], a, pa0, pa1, pa2, pa3);
  vfrag_load<2>(a, vb);
  asm volatile("s_waitcnt lgkmcnt(8)" ::: "memory"); SBAR(); vfrag_mma(o[1], b, pa0, pa1, pa2, pa3);
  vfrag_load<3>(b, vb);
  asm volatile("s_waitcnt lgkmcnt(8)" ::: "memory"); SBAR(); vfrag_mma(o[2], a, pa0, pa1, pa2, pa3);
  asm volatile("s_waitcnt lgkmcnt(0)" ::: "memory"); SBAR(); vfrag_mma(o[3], b, pa0, pa1, pa2, pa3);
}
template <typename TQ, bool SHIFT>
__device__ __forceinline__ void attn_dense_body(const TQ* __restrict__ Qb, const bf16* __restrict__ Kh, const bf16* __restrict__ Vh,
                                                bf16* ZSb, int seq, char* lds, int tid_, int dry, float mnC) {
  constexpr int SDEPTH = SHIFT ? 1 : 2;
  using St = Stage<bf16>; using SQ = Stage<TQ>;
  asm volatile("" : "+v"(tid_));
  const int tid = tid_, wid = __builtin_amdgcn_readfirstlane(tid >> 6), lane0 = tid & 63, r32q = lane0 & 31, hiq = lane0 >> 5;
  bf16* V_lds = (bf16*)lds; bf16* K_lds = (bf16*)(lds + 3 * SHM_V);
  float* ws = (float*)(lds + 3 * SHM_V + 3 * SHM_K) + wid * 64; float* li_l = ws; float* al_l = ws + 32;
  float l_reg = 0; f32x16 o[4] = {}; bf16x8 qr[8];
  const TQ* Qw = Qb + (long)(wid * QBLK + r32q) * LDQ + hiq * 8;
#pragma unroll
  for (int d0 = 0; d0 < 8; ++d0) qr[d0] = SQ::tobf(SQ::ld8(Qw + d0 * 16));
  int lane; asm volatile("v_mbcnt_lo_u32_b32 %0, -1, 0\n\tv_mbcnt_hi_u32_b32 %0, -1, %0" : "=v"(lane));
  const int r32 = lane & 31, hi = lane >> 5;
  const int sr = tid >> 4, sc = (tid & 15) * 8, vst0 = v_st(sr, sc), vst1 = v_st(32 + sr, sc);
  const int vb0 = (int)(uintptr_t)V_lds + v_rd_base(lane);
  struct { typename St::T vs0, vs1, ks0, ks1; } sr_[SDEPTH];
#define SLOAD(i, k0) do { sr_[i].vs0 = St::ld8(&Vh[(long)((k0) + sr) * LDK + sc]); sr_[i].vs1 = St::ld8(&Vh[(long)((k0) + 32 + sr) * LDK + sc]); \
    sr_[i].ks0 = St::ld8(&Kh[(long)((k0) + sr) * LDK + sc]); sr_[i].ks1 = St::ld8(&Kh[(long)((k0) + 32 + sr) * LDK + sc]); } while (0)
#define SWRITE(b, i) do { *(bf16x8*)((char*)V_lds + (b) * SHM_V + vst0) = St::tobf(sr_[i].vs0);          \
    *(bf16x8*)((char*)V_lds + (b) * SHM_V + vst1) = St::tobf(sr_[i].vs1); int kc = sc * 2;               \
    *(bf16x8*)((char*)K_lds + (b) * SHM_K + KSWZ(sr, kc)) = St::tobf(sr_[i].ks0);                       \
    *(bf16x8*)((char*)K_lds + (b) * SHM_K + KSWZ(32 + sr, kc)) = St::tobf(sr_[i].ks1); } while (0)
#define SWAIT() do { if constexpr (SDEPTH == 2) asm volatile("s_waitcnt vmcnt(4)" ::: "memory"); else asm volatile("s_waitcnt vmcnt(0)" ::: "memory"); } while (0)
#define RESC(a) do { if (__any((a) < 1.f)) { if (hi == 0) al_l[r32] = (a); asm volatile("s_waitcnt lgkmcnt(0)" ::: "memory"); \
    for (int d = 0; d < 4; ++d) for (int r = 0; r < 16; ++r) o[d][r] *= al_l[crow(r, hi)]; } } while (0)
  f32x16 pA0, pA1, pB0, pB1; const float alA = 1.f, alB = 1.f; bf16x8 pa0, pa1, pa2, pa3; const int NT = seq / KVBLK;
  constexpr int SE = 0, SO = SDEPTH - 1;
  SLOAD(SE, 0); asm volatile("s_waitcnt vmcnt(0)" ::: "memory"); SWRITE(0, SE); __syncthreads();
  qkt(pA0, pA1, K_lds, qr, r32, hi); partialSMF<SHIFT>(pA0, pA1, mnC);
  SLOAD(SO, KVBLK); if constexpr (SDEPTH == 2) { if (2 < NT) SLOAD(SE, 2 * KVBLK); }
  SWAIT(); SWRITE(1, SO); __syncthreads();
  int cur = 1, prv = 0, nxt = 2;
  for (int j = 1; j + 1 < NT; j += 2) {
    SBAR(); qkt(pB0, pB1, (bf16*)((char*)K_lds + cur * (int)SHM_K), qr, r32, hi);
    finishSM(pA0, pA1, alA, l_reg, pa0, pa1, pa2, pa3); SBAR();
    SLOAD(SO, (j + SDEPTH) * KVBLK);
    pv_d0(o, vb0 + prv * (int)SHM_V, pa0, pa1, pa2, pa3); partialSMF<SHIFT>(pB0, pB1, mnC);
    SWAIT(); SWRITE(nxt, SE); __syncthreads();
    prv = cur; cur = nxt; nxt = (nxt == 2) ? 0 : nxt + 1;
    SBAR(); qkt(pA0, pA1, (bf16*)((char*)K_lds + cur * (int)SHM_K), qr, r32, hi);
    finishSM(pB0, pB1, alB, l_reg, pa0, pa1, pa2, pa3); SBAR();
    if (SDEPTH == 1 || j + 3 < NT) SLOAD(SE, (j + 1 + SDEPTH) * KVBLK);
    pv_d0(o, vb0 + prv * (int)SHM_V, pa0, pa1, pa2, pa3); partialSMF<SHIFT>(pA0, pA1, mnC);
    SWAIT(); SWRITE(nxt, SO); __syncthreads();
    prv = cur; cur = nxt; nxt = (nxt == 2) ? 0 : nxt + 1;
  }
  SBAR(); qkt(pB0, pB1, (bf16*)((char*)K_lds + cur * (int)SHM_K), qr, r32, hi);
  finishSM(pA0, pA1, alA, l_reg, pa0, pa1, pa2, pa3); SBAR();
  pv_d0(o, vb0 + prv * (int)SHM_V, pa0, pa1, pa2, pa3); partialSMF<SHIFT>(pB0, pB1, mnC);
  finishSM(pB0, pB1, alB, l_reg, pa0, pa1, pa2, pa3); SBAR();
  pv_d0(o, vb0 + cur * (int)SHM_V, pa0, pa1, pa2, pa3);
  if (hi == 0) li_l[r32] = l_reg; asm volatile("s_waitcnt lgkmcnt(0)" ::: "memory");
  float rli[16];
#pragma unroll
  for (int r = 0; r < 16; ++r) rli[r] = __builtin_amdgcn_rcpf(li_l[crow(r, hi)]);
  int le; asm volatile("v_mbcnt_lo_u32_b32 %0, -1, 0\n\tv_mbcnt_hi_u32_b32 %0, -1, %0" : "=v"(le));
  const int r32e = le & 31, hie = le >> 5;
  bf16* Zw = ZSb + (long)(wid * QBLK) * LDO;
#pragma unroll
  for (int r = 0; r < 16; ++r) { int orow = crow(r, hie);
    for (int d0 = 0; d0 < 4; ++d0) { bf16* zp = Zw + (long)orow * LDO + d0 * 32 + r32e; const float zs = __builtin_bit_cast(float, (unsigned)(*zp) << 16);
      const float a2 = o[d0][r] * rli[r] * zs; unsigned ub = __builtin_bit_cast(unsigned, a2); if (!dry) *zp = (bf16)((ub + 0x7fffu + ((ub >> 16) & 1u)) >> 16); } }
  __syncthreads();
#undef SLOAD
#undef SWRITE
#undef SWAIT
#undef RESC
}
}
#define XB_TMO      128
#define XB_XCNT(j)  (256  + 64 * (j))
#define XB_XSUB(j)  (1280 + 64 * (j))
#define XB_XGEN(j)  (2304 + 64 * (j))
#define XB_TOP      3328
#define XB_TOPGEN   3392
#define XCD_BAR_WORDS 3456
#define XB_SPIN_CAP (1u << 18)

__device__ __forceinline__ unsigned xb_ld(unsigned* p)              { return __hip_atomic_load(p, __ATOMIC_RELAXED, __HIP_MEMORY_SCOPE_AGENT); }
__device__ __forceinline__ unsigned xb_add(unsigned* p, unsigned v) { return __hip_atomic_fetch_add(p, v, __ATOMIC_RELAXED, __HIP_MEMORY_SCOPE_AGENT); }
__device__ __forceinline__ unsigned xb_xcc_id() { return (unsigned)__builtin_amdgcn_s_getreg((3 << 11) | 20) & 0xFu; }
#define XB_SPIN(cond, bar) do { unsigned _sp = 0; while (cond) { __builtin_amdgcn_s_sleep(1); \
    if ((++_sp & 255u) == 0u) { if (xb_ld(&(bar)[XB_TMO])) break; if (_sp > XB_SPIN_CAP) { atomicAdd(&(bar)[XB_TMO], 1u); break; } } } } while (0)

struct XcdBarrier {
    unsigned* bar; unsigned x;
    volatile LAS unsigned* st;
};

__device__ __forceinline__ XcdBarrier xcd_barrier_post(unsigned* bar, volatile LAS unsigned* st, bool t0) {
    XcdBarrier b; b.bar = bar; b.x = xb_xcc_id(); b.st = st;
    if (t0) (void)xb_add(&bar[XB_XCNT(b.x)], 1u);
    return b;
}
__device__ __forceinline__ void xcd_barrier_complete(unsigned* bar, unsigned x, unsigned& nloc, unsigned& nx) {
    const unsigned G = gridDim.x * gridDim.y * gridDim.z;
    unsigned sum, cnt, mine, sp = 0u;
    for (;;) {
        sum = 0u; cnt = 0u; mine = 0u;
#pragma unroll
        for (unsigned j = 0; j < 16; ++j) { const unsigned c = xb_ld(&bar[XB_XCNT(j)]); sum += c; cnt += (c > 0u) ? 1u : 0u; mine = (j == x) ? c : mine; }
        if (sum == G) break;
        __builtin_amdgcn_s_sleep(1);
        if ((++sp & 255u) == 0u) { if (xb_ld(&bar[XB_TMO])) break; if (sp > XB_SPIN_CAP) { atomicAdd(&bar[XB_TMO], 1u); break; } }
    }
    nloc = mine > 0u ? mine : 1u; nx = cnt > 0u ? cnt : 1u;
}

__device__ __forceinline__ void xcd_barrier(const XcdBarrier& b, bool t0) {
    asm volatile("s_waitcnt vmcnt(0)" ::: "memory");
    __syncthreads();
    if (t0) {
        unsigned* bar = b.bar;
        __builtin_amdgcn_s_waitcnt(0);
        unsigned nloc = b.st[0], nx = b.st[1];
        if (nloc == 0u) { xcd_barrier_complete(bar, b.x, nloc, nx); b.st[0] = nloc; b.st[1] = nx; }
        const unsigned old = xb_add(&bar[XB_XSUB(b.x)], 1u);
        const unsigned gen = old / nloc;
        if (old + 1u == (gen + 1u) * nloc) {
            __builtin_amdgcn_fence(__ATOMIC_RELEASE, "agent");
            asm volatile("s_waitcnt vmcnt(0)" ::: "memory");
            const unsigned og = xb_add(&bar[XB_TOP], 1u);
            const unsigned tg = og / nx;
            if (og + 1u == (tg + 1u) * nx) xb_add(&bar[XB_TOPGEN], 1u);
            else XB_SPIN(xb_ld(&bar[XB_TOPGEN]) == tg, bar);
            __builtin_amdgcn_fence(__ATOMIC_ACQUIRE, "agent");
            xb_add(&bar[XB_XGEN(b.x)], 1u);
            asm volatile("s_waitcnt vmcnt(0)" ::: "memory");
        } else {
            XB_SPIN(xb_ld(&bar[XB_XGEN(b.x)]) == gen, bar);
            __builtin_amdgcn_fence(__ATOMIC_ACQUIRE, "agent");
            asm volatile("s_waitcnt vmcnt(0)" ::: "memory");
        }
    }
    __syncthreads();
}
struct Args {
    const float *x, *c, *ctx, *c_ctx, *norm_g, *ada_w, *ada_b, *hy_w_in, *hy_conv_w, *hy_conv_b, *fw1, *fb1, *fw2, *fb2, *fw3, *fb3, *fw4, *freq, *hy_d, *hy_w_out,
                *at_w_in, *at_q_g, *at_k_g, *at_w_out;
    float* out; unsigned char* ws;
};

template <int MODE> __device__ __forceinline__ int dest_row(int n) {
    if (MODE == 1) { const int s = n >> 11, c = n & 2047, pn = c >> 6, cl = c & 63; return pn * 256 + 128 * (s >> 1) + 32 * (cl >> 4) + 8 * ((cl >> 2) & 3) + 4 * (s & 1) + (cl & 3); }
    if (MODE == 2) { if (n >= 2560) return n; const int hh = n >> 7, dim = n & 127, quarter = dim >> 5, rem = dim & 31;
        return hh * 128 + 32 * (rem >> 3) + 8 * ((rem >> 1) & 3) + 4 * (quarter >> 1) + 2 * (quarter & 1) + (rem & 1); }
    return n;
}
template <int MODE> __device__ __forceinline__ void transpose_item(const float* W, int K, int N, bf16_t* WT, LAS float* scr, int item, int lane) {
    const int nblk = N / 32, kb = item / nblk, nb = item % nblk, k0 = 64 * kb, n0 = 32 * nb;
    float tv[32];
#pragma unroll
    for (int i = 0; i < 32; ++i) { const int kk = 2 * i + (lane >> 5); tv[i] = W[(size_t)(k0 + kk) * N + n0 + (lane & 31)]; }
#pragma unroll
    for (int i = 0; i < 32; ++i) { const int kk = 2 * i + (lane >> 5); scr[kk * 33 + (lane & 31)] = tv[i]; }
    asm volatile("s_waitcnt lgkmcnt(0)" ::: "memory");
    const int c = lane & 7;
#pragma unroll
    for (int j = 0; j < 4; ++j) { const int n = (lane >> 3) + 8 * j; const LAS float* s = scr + (8 * c) * 33 + n;
        u32x4 o; o.x = pk2(s[0 * 33], s[1 * 33]); o.y = pk2(s[2 * 33], s[3 * 33]); o.z = pk2(s[4 * 33], s[5 * 33]); o.w = pk2(s[6 * 33], s[7 * 33]);
        *(u32x4*)(WT + (size_t)dest_row<MODE>(n0 + n) * K + k0 + 8 * c) = o; }
    asm volatile("s_waitcnt lgkmcnt(0)" ::: "memory");
}
__device__ __forceinline__ float red_rev(float x) { const float n = rintf(x * 0.15915494309189535f); float r = fmaf(n, -6.28125f, x); r = fmaf(n, -0.0019353071795864769f, r); return r * 0.15915494309189535f; }
__device__ __forceinline__ float hsin(float x) { return __builtin_amdgcn_sinf(red_rev(x)); }
__device__ __forceinline__ float hcos(float x) { return __builtin_amdgcn_cosf(red_rev(x)); }
__device__ __forceinline__ float rdlane(float v, int k) { return __builtin_bit_cast(float, __builtin_amdgcn_readlane(__builtin_bit_cast(int, v), k)); }
__device__ __forceinline__ void filt_item(const LAS float* fl, int L, int i, bf16_t* orow, int lane) {
    const float t = (float)i / (float)(L - 1);
    const float w = 6.283185307179586f * (float)i / (float)L;
    float zf = 0.f;
    if (lane == 0) zf = t;
    else if (lane <= 32) { const int mi = (lane - 1) & 15; const float fr = 1e-4f + (float)mi * ((15.0f - 1e-4f) / 15.0f); zf = (lane <= 16) ? hcos(fr * w) : -hsin(fr * w); }
    const float fq = fl[10496 + lane];
    float a = fl[10304 + lane];
#pragma unroll 3
    for (int k = 0; k < 33; ++k) a += rdlane(zf, k) * fl[k * 64 + lane];
    float h = hsin(fq * a);
    a = fl[10368 + lane];
#pragma unroll 8
    for (int k = 0; k < 64; ++k) a += rdlane(h, k) * fl[2112 + k * 64 + lane];
    h = hsin(fq * a);
    a = fl[10432 + lane];
#pragma unroll 8
    for (int k = 0; k < 64; ++k) a += rdlane(h, k) * fl[6208 + k * 64 + lane];
    h = hsin(fq * a);
    const unsigned hi = f2bf(h); const unsigned lo = f2bf(h - bf2f((unsigned short)hi));
    orow[lane] = (bf16_t)hi; orow[64 + lane] = (bf16_t)lo; orow[128 + lane] = (bf16_t)hi; orow[192 + lane] = 0;
}
__device__ __forceinline__ void w4x_item(const float* W4, bf16_t* W4X, LAS float* scr, int item, int lane) {
    const int n0 = 32 * item;
    float tv[32];
#pragma unroll
    for (int i = 0; i < 32; ++i) { const int kk = 2 * i + (lane >> 5); tv[i] = W4[(size_t)kk * 4096 + n0 + (lane & 31)]; }
#pragma unroll
    for (int i = 0; i < 32; ++i) { const int kk = 2 * i + (lane >> 5); scr[kk * 33 + (lane & 31)] = tv[i]; }
    asm volatile("s_waitcnt lgkmcnt(0)" ::: "memory");
    const int seg = lane >> 4, kb = (4 * lane) & 63;
    for (int n = 0; n < 32; ++n) {
        unsigned hv[4];
#pragma unroll
        for (int j = 0; j < 4; ++j) { const float x = scr[(kb + j) * 33 + n]; const unsigned hi = f2bf(x); const unsigned lo = f2bf(x - bf2f((unsigned short)hi)); hv[j] = seg < 2 ? hi : (seg == 2 ? lo : 0u); }
        u32x2 o; o.x = hv[0] | (hv[1] << 16); o.y = hv[2] | (hv[3] << 16);
        *(u32x2*)(W4X + (size_t)(n0 + n) * 256 + 4 * lane) = o;
    }
    asm volatile("s_waitcnt lgkmcnt(0)" ::: "memory");
}
__device__ __forceinline__ void norm_row_v(const f32x4 (&v)[4], const float* g, const float* mod, bf16_t* orow, int lane) {
    float s = 0.f;
#pragma unroll
    for (int j = 0; j < 4; ++j) s += (v[j].x * v[j].x + v[j].y * v[j].y) + (v[j].z * v[j].z + v[j].w * v[j].w);
    const float rstd = rsqrtf(wave_sum(s) * (1.f / DM) + EPSN);
#pragma unroll
    for (int j = 0; j < 4; ++j) { const int col = 4 * lane + 256 * j;
        const f32x4 gg = *(const f32x4*)(g + col), sh = *(const f32x4*)(mod + col), sc = *(const f32x4*)(mod + 1024 + col);
        const f32x4 h = v[j] * rstd * gg * (1.f + sc) + sh;
        u32x2 o; o.x = pk2(h.x, h.y); o.y = pk2(h.z, h.w); *(u32x2*)(orow + col) = o; }
}
__device__ __forceinline__ void norm_row(const float* xrow, const float* g, const float* mod, bf16_t* orow, int lane) {
    f32x4 v[4];
#pragma unroll
    for (int j = 0; j < 4; ++j) v[j] = ((const f32x4*)xrow + lane)[64 * j];
    norm_row_v(v, g, mod, orow, lane);
}
__device__ __forceinline__ void norm_row_ctx(const float* xrow, const float* part, const float* gt, const float* g, const float* mod, bf16_t* orow, int lane) {
    f32x4 v[4]; float s = 0.f;
#pragma unroll
    for (int j = 0; j < 4; ++j) { const int col = 4 * lane + 256 * j; f32x4 a = *(const f32x4*)(part + col);
#pragma unroll
        for (int ks = 1; ks < 8; ++ks) a += *(const f32x4*)(part + (size_t)ks * 512 * DM + col);
        v[j] = *(const f32x4*)(xrow + col) + *(const f32x4*)(gt + col) * a;
        s += (v[j].x * v[j].x + v[j].y * v[j].y) + (v[j].z * v[j].z + v[j].w * v[j].w); }
    const float rstd = rsqrtf(wave_sum(s) * (1.f / DM) + EPSN);
#pragma unroll
    for (int j = 0; j < 4; ++j) { const int col = 4 * lane + 256 * j;
        const f32x4 gg = *(const f32x4*)(g + col), sh = *(const f32x4*)(mod + col), sc = *(const f32x4*)(mod + 1024 + col);
        const f32x4 h = v[j] * rstd * gg * (1.f + sc) + sh;
        u32x2 o; o.x = pk2(h.x, h.y); o.y = pk2(h.z, h.w); *(u32x2*)(orow + col) = o; }
}

typedef float cf __attribute__((ext_vector_type(2)));
__device__ __forceinline__ cf cmul(cf a, cf b) { return {a.x * b.x - a.y * b.y, a.x * b.y + a.y * b.x}; }
template <int SGN> __device__ __forceinline__ cf mulw4(cf a) { return SGN > 0 ? cf{-a.y, a.x} : cf{a.y, -a.x}; }
template <int SGN> __device__ __forceinline__ void fft4(cf& a0, cf& a1, cf& a2, cf& a3) {
    const cf s02 = a0 + a2, d02 = a0 - a2, s13 = a1 + a3, d13 = mulw4<SGN>(a1 - a3);
    a0 = s02 + s13; a1 = d02 + d13; a2 = s02 - s13; a3 = d02 - d13;
}
template <int SGN> __device__ __forceinline__ cf tw(float frac) { return {__builtin_amdgcn_cosf(frac), (float)SGN * __builtin_amdgcn_sinf(frac)}; }
template <int SGN> __device__ __forceinline__ void fft16(cf (&v)[16]) {
#pragma unroll
    for (int b = 0; b < 4; ++b) fft4<SGN>(v[b], v[4 + b], v[8 + b], v[12 + b]);
    constexpr float C1 = 0.92387953251128674f, S1 = 0.38268343236508977f, C2 = 0.70710678118654752f;
    const float sg = (float)SGN;
    v[4 * 1 + 1] = cmul(v[4 * 1 + 1], cf{C1, sg * S1});
    v[4 * 1 + 2] = cmul(v[4 * 1 + 2], cf{C2, sg * C2});
    v[4 * 1 + 3] = cmul(v[4 * 1 + 3], cf{S1, sg * C1});
    v[4 * 2 + 1] = cmul(v[4 * 2 + 1], cf{C2, sg * C2});
    v[4 * 2 + 2] = mulw4<SGN>(v[4 * 2 + 2]);
    v[4 * 2 + 3] = cmul(v[4 * 2 + 3], cf{-C2, sg * C2});
    v[4 * 3 + 1] = cmul(v[4 * 3 + 1], cf{S1, sg * C1});
    v[4 * 3 + 2] = cmul(v[4 * 3 + 2], cf{-C2, sg * C2});
    v[4 * 3 + 3] = cmul(v[4 * 3 + 3], cf{-C1, -sg * S1});
#pragma unroll
    for (int c = 0; c < 4; ++c) fft4<SGN>(v[4 * c + 0], v[4 * c + 1], v[4 * c + 2], v[4 * c + 3]);
}
template <int SGN, int STRIDE> __device__ __forceinline__ void fft32_store(const cf (&t)[32], LAS cf* Lw) {
    constexpr float C32[16] = {1.f, 0.98078528040323043f, 0.92387953251128674f, 0.83146961230254524f, 0.70710678118654752f, 0.55557023301960218f, 0.38268343236508977f, 0.19509032201612825f,
                               0.f, -0.19509032201612825f, -0.38268343236508977f, -0.55557023301960218f, -0.70710678118654752f, -0.83146961230254524f, -0.92387953251128674f, -0.98078528040323043f};
    constexpr float S32[16] = {0.f, 0.19509032201612825f, 0.38268343236508977f, 0.55557023301960218f, 0.70710678118654752f, 0.83146961230254524f, 0.92387953251128674f, 0.98078528040323043f,
                               1.f, 0.98078528040323043f, 0.92387953251128674f, 0.83146961230254524f, 0.70710678118654752f, 0.55557023301960218f, 0.38268343236508977f, 0.19509032201612825f};
    cf te[16], to[16];
#pragma unroll
    for (int q = 0; q < 16; ++q) { te[q] = t[2 * q]; to[q] = t[2 * q + 1]; }
    fft16<SGN>(te); fft16<SGN>(to);
#pragma unroll
    for (int k = 0; k < 16; ++k) { const int idx = 4 * (k & 3) + (k >> 2);
        const cf o = (k == 0) ? to[idx] : cmul(to[idx], cf{C32[k], (float)SGN * S32[k]});
        Lw[STRIDE * k] = te[idx] + o; Lw[STRIDE * (k + 16)] = te[idx] - o; }
}
template <int SGN> __device__ __forceinline__ void fft_run(cf (&v)[32], LAS cf* L, int tid) {
    asm volatile("" : "+v"(tid));
    const int pb = tid + (tid >> 5);
    fft32_store<SGN, 1>(v, L + 33 * tid);
    __syncthreads();
#pragma unroll
    for (int q = 0; q < 32; ++q) v[q] = L[pb + 528 * q];
    __syncthreads();
    { const int jm = tid & 31; const float f1 = (float)jm * (1.0f / 1024.0f);
#pragma unroll
      for (int q = 1; q < 32; ++q) v[q] = cmul(v[q], tw<SGN>(f1 * (float)q));
      const int base = (tid >> 5) * 1024 + jm;
      fft32_store<SGN, 33>(v, L + base + (base >> 5)); }
    __syncthreads();
#pragma unroll
    for (int i = 0; i < 2; ++i) { const int j = tid + 512 * i; const float f1 = (float)j * (1.0f / 16384.0f);
        cf t[16];
#pragma unroll
        for (int q = 0; q < 16; ++q) t[q] = L[pb + 528 * i + 1056 * q];
#pragma unroll
        for (int q = 1; q < 16; ++q) t[q] = cmul(t[q], tw<SGN>(f1 * (float)q));
        fft16<SGN>(t);
#pragma unroll
        for (int p = 0; p < 16; ++p) v[i + 2 * p] = t[4 * (p & 3) + (p >> 2)];
        __builtin_amdgcn_sched_barrier(0); }
    __syncthreads();
}
__device__ __forceinline__ float block_sum(float v, LAS float* red, int tid) {
    v = wave_sum(v);
    if ((tid & 63) == 0) red[tid >> 6] = v;
    __syncthreads();
    float s = 0.f;
#pragma unroll
    for (int i = 0; i < 8; ++i) s += red[i];
    __syncthreads();
    return s;
}
#ifndef DBL
#define DBL 0
#endif
__device__ __forceinline__ const Args& kargs_ref() {
#if defined(__HIP_DEVICE_COMPILE__)
    typedef const __attribute__((address_space(4))) Args* KArgP;
    KArgP p = (KArgP)__builtin_amdgcn_kernarg_segment_ptr(); asm volatile("" : "+s"(p)); return *(const Args*)p;
#else
    static Args dummy; return dummy;
#endif
}
__global__ void __launch_bounds__(NTHR, 2) mk_fwd(Args Akern) {
    extern __shared__ __attribute__((aligned(16))) unsigned char lds_raw[];
    cg::grid_group grid = cg::this_grid();
    LAS unsigned char* lds = (LAS unsigned char*)lds_raw;
    const int G = gridDim.x, bx = blockIdx.x;
    const int wave_s = __builtin_amdgcn_readfirstlane((int)threadIdx.x >> 6);
    if (threadIdx.x < 2) ((LAS unsigned*)(lds + LDS_MISC))[threadIdx.x] = 0u;
    __syncthreads();
    (void)xcd_barrier_post((unsigned*)(kargs_ref().ws + WS_CTL), (volatile LAS unsigned*)(lds + LDS_MISC), threadIdx.x == 0);
#define GRID_BAR() do { int tb_; asm volatile("v_mbcnt_lo_u32_b32 %0, -1, 0\n\tv_mbcnt_hi_u32_b32 %0, -1, %0" : "=v"(tb_)); XcdBarrier xb_; xb_.bar = (unsigned*)(kargs_ref().ws + WS_CTL); xb_.x = xb_xcc_id(); \
        xb_.st = (volatile LAS unsigned*)(lds + LDS_MISC); xcd_barrier(xb_, wave_s == 0 && tb_ == 0); } while (0)
#define MOD ((float*)(ws + WS_MOD))
#define H3X ((bf16_t*)(ws + WS_H3X))
#define W4X ((bf16_t*)(ws + WS_W4X))
#define ROPE ((float*)(ws + WS_ROPE))
#define KTC ((float*)(ws + WS_KTC))
#define X1C ((float*)(ws + WS_X1C))
#define WIN ((bf16_t*)(ws + WS_WIN))
#define WOUT ((bf16_t*)(ws + WS_WOUT))
#define AWIN ((bf16_t*)(ws + WS_AWIN))
#define AWOUT ((bf16_t*)(ws + WS_AWOUT))
#define H ((bf16_t*)(ws + WS_H))
#define S ((float*)(ws + WS_S))
#define UT ((bf16_t*)(ws + WS_UT))
#define GB ((bf16_t*)(ws + WS_G))
#define Q ((bf16_t*)(ws + WS_Q))
#define ZS ((bf16_t*)(ws + WS_ZS))
#define KB ((bf16_t*)(ws + WS_KB))
#define VB ((bf16_t*)(ws + WS_VB))
#define KT ((bf16_t*)A.out)
#ifdef PROBE_K
#define STAMP(k) do { if (bx == 0 && threadIdx.x == 0) ((unsigned long long*)(kargs_ref().ws + 8192))[k] = __builtin_amdgcn_s_memrealtime(); } while (0)
#else
#define STAMP(k) do { } while (0)
#endif
    STAMP(0);
    _Pragma("unroll") for (int rep_ = 0; rep_ < ((((DBL) >> 0) & 1) ? 2 : 1); ++rep_) { if (rep_) GRID_BAR();
        const Args& A = kargs_ref(); unsigned char* ws = A.ws; int tid_; asm volatile("v_mbcnt_lo_u32_b32 %0, -1, 0\n\tv_mbcnt_hi_u32_b32 %0, -1, %0" : "=v"(tid_)); tid_ += wave_s * 64; const int tid = tid_, lane = tid & 63, wave = __builtin_amdgcn_readfirstlane(tid >> 6), gw = bx * 8 + wave, NGW = G * 8; (void)lane; (void)gw; (void)NGW;
        LAS float* scr = (LAS float*)(lds + wave * 8448);
        LAS float* fl = (LAS float*)(lds + 73728);
        for (int e2 = tid; e2 < 2112; e2 += NTHR) fl[e2] = A.fw1[e2];
        for (int e2 = tid; e2 < 4096; e2 += NTHR) { fl[2112 + e2] = A.fw2[e2]; fl[6208 + e2] = A.fw3[e2]; }
        if (tid < 64) { fl[10304 + tid] = A.fb1[tid]; fl[10368 + tid] = A.fb2[tid]; fl[10432 + tid] = A.fb3[tid]; fl[10496 + tid] = A.freq[tid]; }
        __syncthreads();
        constexpr int I0 = 16 * 256, I1 = 16 * 160, I2 = 32 * 32, I3 = 32 * 32, I4 = 128;
        for (int it = gw; it < I0 + I1 + I2 + I3 + I4; it += NGW) {
            int r = it;
            if (r < I0) { transpose_item<1>(A.hy_w_in, 1024, 8192, WIN, scr, r, lane); continue; } r -= I0;
            if (r < I1) { transpose_item<2>(A.at_w_in, 1024, 5120, AWIN, scr, r, lane); continue; } r -= I1;
            if (r < I2) { transpose_item<0>(A.hy_w_out, 2048, 1024, WOUT, scr, r, lane); continue; } r -= I2;
            if (r < I3) { transpose_item<0>(A.at_w_out, 2048, 1024, AWOUT, scr, r, lane); continue; } r -= I3;
            w4x_item(A.fw4, W4X, scr, r, lane);
        }
        for (int it = gw; it < LSEQ + CTX; it += NGW) filt_item(fl, it < LSEQ ? LSEQ : CTX, it < LSEQ ? it : it - LSEQ, H3X + (size_t)it * 256, lane);
        for (int it = bx * NTHR + tid; it < 128 * 32; it += G * NTHR) { const int pos = it >> 5, f = it & 31; const float inv = __builtin_amdgcn_exp2f(-(float)f * (13.287712379549449f / 32.0f)); const float ang = (float)pos * inv;
            ROPE[it * 2] = hcos(ang); ROPE[it * 2 + 1] = hsin(ang); }
        __syncthreads();
        if (bx < 96) {
            LAS float* sl = (LAS float*)lds;
            LAS float* part = (LAS float*)(lds + 16384);
            for (int e2 = tid; e2 < 3072; e2 += NTHR) { const int k = e2 & 1023; sl[e2] = silu_f(e2 < 2048 ? A.c[e2] : A.c_ctx[k]); }
            __syncthreads();
            for (int it = bx; it < 96; it += G) {
                const int l = it / 48, n = (it % 48) * 64 + lane;
                const float* W = A.ada_w + (size_t)l * 1024 * 3072 + n;
                float a0 = 0.f, a1 = 0.f, a2 = 0.f;
#pragma unroll 32
                for (int k = wave * 128; k < wave * 128 + 128; ++k) { const float wv = W[(size_t)k * 3072]; a0 += sl[k] * wv; a1 += sl[1024 + k] * wv; a2 += sl[2048 + k] * wv; }
                part[(wave * 3 + 0) * 64 + lane] = a0; part[(wave * 3 + 1) * 64 + lane] = a1; part[(wave * 3 + 2) * 64 + lane] = a2;
                __syncthreads();
                if (wave < 3) { float s = A.ada_b[l * 3072 + n];
#pragma unroll
                    for (int w8 = 0; w8 < 8; ++w8) s += part[(w8 * 3 + wave) * 64 + lane];
                    MOD[(l * 3 + wave) * 3072 + n] = s; }
                __syncthreads();
            }
        }
    }
    if (gridDim.y == 0x7fffffffu) grid.sync();
    GRID_BAR();
    STAMP(1);
    _Pragma("unroll") for (int rep_ = 0; rep_ < ((((DBL) >> 1) & 1) ? 2 : 1); ++rep_) { if (rep_) GRID_BAR();
        const Args& A = kargs_ref(); unsigned char* ws = A.ws; int tid_; asm volatile("v_mbcnt_lo_u32_b32 %0, -1, 0\n\tv_mbcnt_hi_u32_b32 %0, -1, %0" : "=v"(tid_)); tid_ += wave_s * 64; const int tid = tid_, lane = tid & 63, wave = __builtin_amdgcn_readfirstlane(tid >> 6), gw = bx * 8 + wave, NGW = G * 8; (void)lane; (void)gw; (void)NGW;
        { f32x4 v[4], vn[4];
#define XROW(m_) ((m_) < MLAT ? A.x + (size_t)(m_) * DM : A.ctx + (size_t)((m_) - MLAT) * DM)
          if (gw < MALL) {
#pragma unroll
              for (int j = 0; j < 4; ++j) v[j] = ((const f32x4*)XROW(gw) + lane)[64 * j]; }
          for (int m = gw; m < MALL; m += NGW) { const int src = m < LSEQ ? 0 : (m < MLAT ? 1 : 2), mn = m + NGW;
              if (mn < MALL) {
#pragma unroll
                  for (int j = 0; j < 4; ++j) vn[j] = ((const f32x4*)XROW(mn) + lane)[64 * j]; }
              norm_row_v(v, A.norm_g, MOD + src * 3072, H + (size_t)m * DM, lane);
#pragma unroll
              for (int j = 0; j < 4; ++j) v[j] = vn[j]; }
#undef XROW
        }
    }
    GRID_BAR();
    STAMP(2);
    _Pragma("unroll") for (int rep_ = 0; rep_ < ((((DBL) >> 2) & 1) ? 2 : 1); ++rep_) { if (rep_) GRID_BAR();
        const Args& A = kargs_ref(); unsigned char* ws = A.ws; int tid_; asm volatile("v_mbcnt_lo_u32_b32 %0, -1, 0\n\tv_mbcnt_hi_u32_b32 %0, -1, %0" : "=v"(tid_)); tid_ += wave_s * 64; const int tid = tid_, lane = tid & 63, wave = __builtin_amdgcn_readfirstlane(tid >> 6), gw = bx * 8 + wave, NGW = G * 8; (void)lane; (void)gw; (void)NGW;
        pg8::Gemm g{H, WIN, MALL, 8192, 1024}; int bxl = bx, Gl = G; asm volatile("" : "+s"(bxl), "+s"(Gl)); pg8::StaticOrder So; So.init(MALL, 8192, Gl, bxl, 1024);
        pg8::EpiHy E{A.hy_conv_w, A.hy_conv_b, UT, GB, S, lds + LDS_XCH};
        pg8::gemm_phase<pg8::EpiHy, pg8::StaticOrder, true, true>(lds, g, So, E, tid_);
        { const int nun = (MALL / 256) * (8192 / 256), rem = nun % Gl; const bool all = (rem == 0);
          if (all || bxl >= rem) {
              pg8::Gemm g2{W4X, H3X, 4096, LSEQ + CTX, 256}; pg8::StaticOrder So2; So2.init(4096, LSEQ + CTX, all ? Gl : Gl - rem, all ? bxl : bxl - rem, 256);
              pg8::EpiKgen E2{KT, KTC};
              pg8::gemm_phase<pg8::EpiKgen, pg8::StaticOrder, true, true>(lds, g2, So2, E2, tid_); } }
    }
    GRID_BAR();
    STAMP(3);
    _Pragma("unroll") for (int rep_ = 0; rep_ < ((((DBL) >> 3) & 1) ? 2 : 1); ++rep_) { if (rep_) GRID_BAR();
        const Args& A = kargs_ref(); unsigned char* ws = A.ws; int tid_; asm volatile("v_mbcnt_lo_u32_b32 %0, -1, 0\n\tv_mbcnt_hi_u32_b32 %0, -1, %0" : "=v"(tid_)); tid_ += wave_s * 64; const int tid = tid_, lane = tid & 63, wave = __builtin_amdgcn_readfirstlane(tid >> 6), gw = bx * 8 + wave, NGW = G * 8; (void)lane; (void)gw; (void)NGW;
        for (int it = bx * NTHR + tid; it < NSTRIP * 2 * 512; it += G * NTHR) {
            const int c0 = (it & 511) * 4, ri = it >> 9, strip = ri >> 1, which = ri & 1;
            const int row = strip * 64 + (which ? 63 : 0);
            const bool seq_start = (row & (LSEQ - 1)) == 0 || (row >= MLAT && (row & 255) == 0);
            const bool seq_end = ((row + 1) & (LSEQ - 1)) == 0 || (row >= MLAT && ((row + 1) & 255) == 0);
            const float* Sp; const float* Sc; const float* Sn; bool zp = false, zn = false;
            if (which == 0) { zp = seq_start; Sp = S + (size_t)(((zp ? strip : strip - 1) * 4 + 3) * 4) * 2048; Sc = S + (size_t)((strip * 4 + 0) * 4) * 2048; Sn = S + (size_t)((strip * 4 + 1) * 4) * 2048; }
            else { zn = seq_end; Sp = S + (size_t)((strip * 4 + 2) * 4) * 2048; Sc = S + (size_t)((strip * 4 + 3) * 4) * 2048; Sn = S + (size_t)(((zn ? strip : strip + 1) * 4 + 0) * 4) * 2048; }
            f32x4 cv[3];
#pragma unroll
            for (int s = 0; s < 3; ++s) {
                f32x4 pv = *(const f32x4*)(Sp + s * 2048 + c0), cur = *(const f32x4*)(Sc + s * 2048 + c0), nx = *(const f32x4*)(Sn + s * 2048 + c0);
                if (zp) pv = (f32x4){0.f, 0.f, 0.f, 0.f}; if (zn) nx = (f32x4){0.f, 0.f, 0.f, 0.f};
                cv[s] = *(const f32x4*)(A.hy_conv_w + 0 * 6144 + s * 2048 + c0) * pv + *(const f32x4*)(A.hy_conv_w + 1 * 6144 + s * 2048 + c0) * cur
                      + *(const f32x4*)(A.hy_conv_w + 2 * 6144 + s * 2048 + c0) * nx + *(const f32x4*)(A.hy_conv_b + s * 2048 + c0);
            }
            const f32x4 z = *(const f32x4*)(Sc + 3 * 2048 + c0);
            const f32x4 uu = cv[1] * cv[2]; f32x4 g;
#pragma unroll
            for (int j = 0; j < 4; ++j) { g[j] = cv[0][j] * silu_f(z[j]); UT[(size_t)(c0 + j) * MALL + row] = (bf16_t)f2bf(uu[j]); }
            u32x2 gw2; gw2.x = pk2(g[0], g[1]); gw2.y = pk2(g[2], g[3]);
            *(u32x2*)(GB + (size_t)row * 2048 + c0) = gw2;
        }
    }
    GRID_BAR();
    STAMP(4);
    _Pragma("unroll") for (int rep_ = 0; rep_ < ((((DBL) >> 4) & 1) ? 2 : 1); ++rep_) { if (rep_) GRID_BAR();
        int dry = (((DBL) >> 4) & 1) && rep_ == 0; asm volatile("" : "+s"(dry));
        const Args& A = kargs_ref(); unsigned char* ws = A.ws; int tid_; asm volatile("v_mbcnt_lo_u32_b32 %0, -1, 0\n\tv_mbcnt_hi_u32_b32 %0, -1, %0" : "=v"(tid_)); tid_ += wave_s * 64; const int tid = tid_, lane = tid & 63, wave = __builtin_amdgcn_readfirstlane(tid >> 6), gw = bx * 8 + wave, NGW = G * 8; (void)lane; (void)gw; (void)NGW;
        LAS cf* L = (LAS cf*)lds; LAS float* red = (LAS float*)(lds + 139264); LAS float* Lf = (LAS float*)lds;
        unsigned short kraw[32];
#define P4_LOADK(chn) do { const bf16_t* kf_ = KT + (size_t)(chn) * 2 * LSEQ; const bf16_t* kb_ = kf_ + LSEQ; \
            _Pragma("unroll") for (int m = 0; m < 32; ++m) { const int pos = tid + 512 * m; int ix = 2 * LSEQ - pos; ix = ix > LSEQ - 1 ? LSEQ - 1 : ix; kraw[m] = (m < 16) ? kf_[pos] : kb_[ix]; } } while (0)
        { int tl = tid_; asm volatile("" : "+v"(tl));
#define tid tl
          if (bx < EH) P4_LOADK(bx);
#undef tid
        }
        for (int ch = bx; ch < EH; ch += G) {
            int tl = tid_; asm volatile("" : "+v"(tl));
#define tid tl
            cf v[32];
            bf16_t* u0 = UT + (size_t)ch * MALL;
            float asum = 0.f;
#pragma unroll
            for (int m = 0; m < 32; ++m) { float kv = bf2f(kraw[m]); if (m == 16) kv = (tid == 0) ? 0.f : kv; asum += fabsf(kv); v[m] = cf{kv, 0.f}; }
            unsigned short ura[16], urb[16];
#pragma unroll
            for (int m = 0; m < 16; ++m) { const int pos = tid + 512 * m; ura[m] = u0[pos]; urb[m] = u0[LSEQ + pos]; }
            { const float ws_ = wave_sum(asum); if ((tid & 63) == 0) red[tid >> 6] = ws_; }
            fft_run<-1>(v, L, tid);
            float tot = 0.f;
#pragma unroll
            for (int i8 = 0; i8 < 8; ++i8) tot += red[i8];
            const float sc = 1.0f / (tot * 16384.0f);
            f32x4* KS = (f32x4*)(ws + WS_S) + (size_t)bx * 8192 + tid;
#pragma unroll
            for (int m = 0; m < 32; m += 2) KS[512 * (m >> 1)] = (f32x4){v[m].x * sc, v[m].y * sc, v[m + 1].x * sc, v[m + 1].y * sc};
#pragma unroll
            for (int m = 0; m < 32; ++m) v[m] = (m < 16) ? cf{bf2f(ura[m]), bf2f(urb[m])} : cf{0.f, 0.f};
            fft_run<-1>(v, L, tid);
#pragma unroll
            for (int m = 0; m < 32; m += 2) { const f32x4 kk = KS[512 * (m >> 1)]; v[m] = cmul(v[m], cf{kk.x, kk.y}); v[m + 1] = cmul(v[m + 1], cf{kk.z, kk.w}); }
            asm volatile("" : "+v"(tl));
#pragma unroll
            for (int m = 0; m < 16; ++m) { const int pos = tid + 512 * m; ura[m] = u0[pos]; urb[m] = u0[LSEQ + pos]; }
            const unsigned short ucr = u0[MLAT + tid]; const float kc = KTC[(size_t)ch * 512 + tid];
            fft_run<1>(v, L, tid);
            asm volatile("" : "+v"(tl));
            const float dsk = A.hy_d[ch];
#pragma unroll
            for (int m = 0; m < 16; ++m) { const int pos = tid + 512 * m;
                if (!dry) { u0[pos] = (bf16_t)f2bf(v[m].x + dsk * bf2f(ura[m])); u0[LSEQ + pos] = (bf16_t)f2bf(v[m].y + dsk * bf2f(urb[m])); } }
            if (ch + G < EH) P4_LOADK(ch + G);
            const float uc = bf2f(ucr);
            Lf[tid] = uc; { const int dir = tid >> 8, tq = tid & 255; if (dir == 0) Lf[512 + 255 + tq] = kc; else if (tq > 0) Lf[512 + 255 - tq] = kc; }
            { const float ws_ = wave_sum((tid == 256) ? 0.f : fabsf(kc)); if ((tid & 63) == 0) red[8 + (tid >> 6)] = ws_; }
            __syncthreads();
            float acc;
            { const int t = tid & 255, s0 = (tid >> 8) * 128; const LAS float* kp = Lf + 512 + 255 + t - s0; const LAS float* up = Lf + s0; float a0 = 0.f, a1 = 0.f;
#pragma unroll 8
              for (int g = 0; g < 32; ++g) { const f32x4 ua4 = *(const LAS f32x4*)(up + 4 * g), ub4 = *(const LAS f32x4*)(up + 256 + 4 * g);
                  const float k0 = kp[-4 * g], k1 = kp[-4 * g - 1], k2 = kp[-4 * g - 2], k3 = kp[-4 * g - 3];
                  a0 += k0 * ua4.x + k1 * ua4.y + k2 * ua4.z + k3 * ua4.w; a1 += k0 * ub4.x + k1 * ub4.y + k2 * ub4.z + k3 * ub4.w; }
              LAS float* Lp = Lf + 1536;
              Lp[(tid >> 8) * 512 + t] = a0; Lp[(tid >> 8) * 512 + 256 + t] = a1;
              __syncthreads();
              acc = Lp[tid] + Lp[512 + tid]; }
            float totc = 0.f;
#pragma unroll
            for (int i8 = 0; i8 < 8; ++i8) totc += red[8 + i8];
            if (!dry) u0[MLAT + tid] = (bf16_t)f2bf(acc / totc + dsk * uc);
            __syncthreads();
#undef tid
        }
    }
    GRID_BAR();
    STAMP(5);
    _Pragma("unroll") for (int rep_ = 0; rep_ < ((((DBL) >> 5) & 1) ? 2 : 1); ++rep_) { if (rep_) GRID_BAR();
        const Args& A = kargs_ref(); unsigned char* ws = A.ws; int tid_; asm volatile("v_mbcnt_lo_u32_b32 %0, -1, 0\n\tv_mbcnt_hi_u32_b32 %0, -1, %0" : "=v"(tid_)); tid_ += wave_s * 64; const int tid = tid_, lane = tid & 63, wave = __builtin_amdgcn_readfirstlane(tid >> 6), gw = bx * 8 + wave, NGW = G * 8; (void)lane; (void)gw; (void)NGW;
        LAS bf16_t* T = (LAS bf16_t*)lds;
        const int chn = tid >> 3, rc = tid & 7, row = tid >> 3, cc = tid & 7;
        constexpr int NT5 = NSTRIP * 32;
        u32x4 q = {0u, 0u, 0u, 0u}, gq = {0u, 0u, 0u, 0u};
        if (bx < NT5) { const int r0 = (bx >> 5) * 64, c0 = (bx & 31) * 64; q = *(const u32x4*)(UT + (size_t)(c0 + chn) * MALL + r0 + 8 * rc); gq = *(const u32x4*)(GB + (size_t)(r0 + row) * 2048 + c0 + 8 * cc); }
        for (int it = bx; it < NT5; it += G) {
            const int r0 = (it >> 5) * 64, c0 = (it & 31) * 64, itn = it + G;
            u32x4 qn = q, gqn = gq;
            if (itn < NT5) { const int r1 = (itn >> 5) * 64, c1 = (itn & 31) * 64; qn = *(const u32x4*)(UT + (size_t)(c1 + chn) * MALL + r1 + 8 * rc); gqn = *(const u32x4*)(GB + (size_t)(r1 + row) * 2048 + c1 + 8 * cc); }
#pragma unroll
            for (int e2 = 0; e2 < 4; ++e2) { T[(8 * rc + 2 * e2) * 68 + chn] = (bf16_t)(q[e2] & 0xffffu); T[(8 * rc + 2 * e2 + 1) * 68 + chn] = (bf16_t)(q[e2] >> 16); }
            __syncthreads();
            { u32x4 o;
#pragma unroll
              for (int e2 = 0; e2 < 4; ++e2) { const float y0 = bf2f(T[row * 68 + 8 * cc + 2 * e2]), y1 = bf2f(T[row * 68 + 8 * cc + 2 * e2 + 1]);
                  o[e2] = pk2(y0 * bf2f((bf16_t)(gq[e2] & 0xffffu)), y1 * bf2f((bf16_t)(gq[e2] >> 16))); }
              *(u32x4*)(GB + (size_t)(r0 + row) * 2048 + c0 + 8 * cc) = o; }
            __syncthreads();
            q = qn; gq = gqn;
        }
    }
    GRID_BAR();
    STAMP(6);
    _Pragma("unroll") for (int rep_ = 0; rep_ < ((((DBL) >> 6) & 1) ? 2 : 1); ++rep_) { if (rep_) GRID_BAR();
        const Args& A = kargs_ref(); unsigned char* ws = A.ws; int tid_; asm volatile("v_mbcnt_lo_u32_b32 %0, -1, 0\n\tv_mbcnt_hi_u32_b32 %0, -1, %0" : "=v"(tid_)); tid_ += wave_s * 64; const int tid = tid_, lane = tid & 63, wave = __builtin_amdgcn_readfirstlane(tid >> 6), gw = bx * 8 + wave, NGW = G * 8; (void)lane; (void)gw; (void)NGW;
        pg8::Gemm g{GB, WOUT, MALL, 1024, 2048}; int bxl = bx, Gl = G; asm volatile("" : "+s"(bxl), "+s"(Gl)); pg8::OrderP6 So; So.init(Gl, bxl);
        pg8::EpiRes6 E{A.x, A.out, MOD, (float*)(ws + WS_UT)};
        pg8::gemm_phase<pg8::EpiRes6, pg8::OrderP6, true, true>(lds, g, So, E, tid_);
    }
    GRID_BAR();
    STAMP(7);
    _Pragma("unroll") for (int rep_ = 0; rep_ < ((((DBL) >> 7) & 1) ? 2 : 1); ++rep_) { if (rep_) GRID_BAR();
        const Args& A = kargs_ref(); unsigned char* ws = A.ws; int tid_; asm volatile("v_mbcnt_lo_u32_b32 %0, -1, 0\n\tv_mbcnt_hi_u32_b32 %0, -1, %0" : "=v"(tid_)); tid_ += wave_s * 64; const int tid = tid_, lane = tid & 63, wave = __builtin_amdgcn_readfirstlane(tid >> 6), gw = bx * 8 + wave, NGW = G * 8; (void)lane; (void)gw; (void)NGW;
        { f32x4 v[4], vn[4];
#pragma unroll
          for (int j = 0; j < 4; ++j) v[j] = ((const f32x4*)(A.out + (size_t)gw * DM) + lane)[64 * j];
          for (int m = gw; m < MLAT; m += NGW) { const int mn = m + NGW;
              if (mn < MLAT) {
#pragma unroll
                  for (int j = 0; j < 4; ++j) vn[j] = ((const f32x4*)(A.out + (size_t)mn * DM) + lane)[64 * j]; }
              norm_row_v(v, A.norm_g + DM, MOD + (3 + (m < LSEQ ? 0 : 1)) * 3072, H + (size_t)m * DM, lane);
#pragma unroll
              for (int j = 0; j < 4; ++j) v[j] = vn[j]; }
        }
        for (int m = gw; m < NB * CTX; m += NGW) norm_row_ctx(A.ctx + (size_t)m * DM, (const float*)(ws + WS_UT) + (size_t)m * DM, MOD + 2 * 3072 + 2048, A.norm_g + DM, MOD + 5 * 3072, H + (size_t)(MLAT + m) * DM, lane);
    }
    GRID_BAR();
    STAMP(8);
    _Pragma("unroll") for (int rep_ = 0; rep_ < ((((DBL) >> 8) & 1) ? 2 : 1); ++rep_) { if (rep_) GRID_BAR();
        const Args& A = kargs_ref(); unsigned char* ws = A.ws; int tid_; asm volatile("v_mbcnt_lo_u32_b32 %0, -1, 0\n\tv_mbcnt_hi_u32_b32 %0, -1, %0" : "=v"(tid_)); tid_ += wave_s * 64; const int tid = tid_, lane = tid & 63, wave = __builtin_amdgcn_readfirstlane(tid >> 6), gw = bx * 8 + wave, NGW = G * 8; (void)lane; (void)gw; (void)NGW;
        pg8::Gemm g{H, AWIN, MALL, 5120, 1024}; int bxl = bx, Gl = G; asm volatile("" : "+s"(bxl), "+s"(Gl)); pg8::StaticOrder So; So.init(MALL, 5120, Gl, bxl, 1024);
        pg8::EpiQKV E{A.at_q_g, A.at_k_g, ROPE, Q, KB, VB, ZS, (LAS float*)(lds + LDS_XCH)};
        pg8::gemm_phase<pg8::EpiQKV, pg8::StaticOrder, true, true>(lds, g, So, E, tid_);
    }
    GRID_BAR();
    STAMP(9);
    _Pragma("unroll") for (int rep_ = 0; rep_ < ((((DBL) >> 9) & 1) ? 2 : 1); ++rep_) { if (rep_) GRID_BAR();
        int dry = (((DBL) >> 9) & 1) && rep_ == 0; asm volatile("" : "+s"(dry));
        const Args& A = kargs_ref(); unsigned char* ws = A.ws; int tid_; asm volatile("v_mbcnt_lo_u32_b32 %0, -1, 0\n\tv_mbcnt_hi_u32_b32 %0, -1, %0" : "=v"(tid_)); tid_ += wave_s * 64; const int tid = tid_, lane = tid & 63, wave = __builtin_amdgcn_readfirstlane(tid >> 6), gw = bx * 8 + wave, NGW = G * 8; (void)lane; (void)gw; (void)NGW;
        float gmq = fmaxf(fabsf(A.at_q_g[lane]), fabsf(A.at_q_g[64 + lane])), gmk = fmaxf(fabsf(A.at_k_g[lane]), fabsf(A.at_k_g[64 + lane]));
#pragma unroll
        for (int o = 1; o < 64; o <<= 1) { gmq = fmaxf(gmq, __shfl_xor(gmq, o)); gmk = fmaxf(gmk, __shfl_xor(gmk, o)); }
        const float mnCv = -(128.0f * 1.02f) * gmq * gmk * (att::SCALE * 1.4426950408889634f);
        const float mnC = __builtin_bit_cast(float, __builtin_amdgcn_readfirstlane(__builtin_bit_cast(int, mnCv)));
#define P9_LOOP(SH) for (int un = bx; un < NB * 16 * 32; un += G) { \
            const int qb = un & 31, gq = (un >> 5) & 3, kvh = (un >> 7) & 3, b = un >> 9, h = kvh * 4 + gq; \
            const size_t qoff = ((size_t)(b * LSEQ + qb * 256)) * 2048 + h * 128, koff = ((size_t)(b * 4 + kvh) * SKV) * 128; \
            int t2; asm volatile("v_mbcnt_lo_u32_b32 %0, -1, 0\n\tv_mbcnt_hi_u32_b32 %0, -1, %0" : "=v"(t2)); t2 += wave_s * 64; \
            att::attn_dense_body<att::bf16, SH>(Q + qoff, KB + koff, VB + koff, ZS + qoff, SKV, (char*)lds_raw, t2, dry, mnC); }
        if (mnC < -100.0f) { P9_LOOP(true) } else { P9_LOOP(false) }
#undef P9_LOOP
    }
    GRID_BAR();
    STAMP(10);
    _Pragma("unroll") for (int rep_ = 0; rep_ < ((((DBL) >> 10) & 1) ? 2 : 1); ++rep_) { if (rep_) GRID_BAR();
        const Args& A = kargs_ref(); unsigned char* ws = A.ws; int tid_; asm volatile("v_mbcnt_lo_u32_b32 %0, -1, 0\n\tv_mbcnt_hi_u32_b32 %0, -1, %0" : "=v"(tid_)); tid_ += wave_s * 64; const int tid = tid_, lane = tid & 63, wave = __builtin_amdgcn_readfirstlane(tid >> 6), gw = bx * 8 + wave, NGW = G * 8; (void)lane; (void)gw; (void)NGW;
        pg8::Gemm g{ZS, AWOUT, MLAT, 1024, 2048}; int bxl = bx, Gl = G; asm volatile("" : "+s"(bxl), "+s"(Gl)); pg8::StaticOrder So; So.init(MLAT, 1024, Gl, bxl, 2048);
        pg8::EpiRes E{A.out, A.out, A.out, A.out, MOD + 3 * 3072};
        pg8::gemm_phase<pg8::EpiRes, pg8::StaticOrder, true, true>(lds, g, So, E, tid_);
    }
#ifdef PROBE_K
    GRID_BAR();
    STAMP(11);
    if (bx == 0 && threadIdx.x == 0) { const unsigned long long* ts = (const unsigned long long*)(kargs_ref().ws + 8192); __builtin_amdgcn_s_waitcnt(0);
        kargs_ref().out[0] = (float)(ts[PROBE_K + 1] - ts[PROBE_K]) * 0.01f; }
#endif
}

extern "C" void kernel_launch(void* const* d_in, const int* in_sizes, int n_in, void* d_out, int out_size, void* d_ws, size_t ws_size, hipStream_t stream) {
    static int grid = 0;
    if (grid == 0) {
        if (n_in != 24 || out_size != MLAT * DM || ws_size < WS_END) { fprintf(stderr, "kernel_launch: unexpected shapes (n_in %d out %d ws %zu)\n", n_in, out_size, ws_size); grid = -1; return; }
        int dev = 0, cus = 0, per_cu = 0;
        (void)hipGetDevice(&dev); (void)hipDeviceGetAttribute(&cus, hipDeviceAttributeMultiprocessorCount, dev);
        if (hipFuncSetAttribute((const void*)mk_fwd, hipFuncAttributeMaxDynamicSharedMemorySize, LDS_BYTES) != hipSuccess) { fprintf(stderr, "kernel_launch: hipFuncSetAttribute failed\n"); grid = -1; return; }
        if (hipOccupancyMaxActiveBlocksPerMultiprocessor(&per_cu, (const void*)mk_fwd, NTHR, LDS_BYTES) != hipSuccess || per_cu < 1) { fprintf(stderr, "kernel_launch: occupancy query says %d\n", per_cu); per_cu = 1; }
        (void)hipGetLastError();
        grid = cus;
    }
    if (grid < 0) return;
    if (hipMemsetAsync((char*)d_ws + WS_CTL, 0, CTL_ZERO_BYTES, stream) != hipSuccess) { fprintf(stderr, "kernel_launch: memset failed\n"); return; }
    Args a{};
    const float** p = (const float**)&a;
    for (int i = 0; i < 24; ++i) p[i] = (const float*)d_in[i];
    a.out = (float*)d_out; a.ws = (unsigned char*)d_ws;
    void* args[] = {&a};
    hipError_t e = hipLaunchCooperativeKernel((const void*)mk_fwd, dim3(grid), dim3(NTHR), args, LDS_BYTES, stream);
    if (e != hipSuccess) fprintf(stderr, "cooperative launch failed: %s (grid %d)\n", hipGetErrorString(e), grid);
}
```

```cpp
#include <hip/hip_runtime.h>
#include <hip/hip_cooperative_groups.h>
#include <cstdio>
#include <cstdint>
namespace cg = cooperative_groups;

#define LAS __attribute__((address_space(3)))
typedef unsigned short bf16_t;
typedef float f32x4 __attribute__((ext_vector_type(4)));
typedef unsigned u32x4 __attribute__((ext_vector_type(4)));
typedef unsigned u32x2 __attribute__((ext_vector_type(2)));

constexpr int DM = 1024, LSEQ = 8192, NB = 2, CTX = 256, EH = 2048;
constexpr int MLAT = NB * LSEQ, MALL = MLAT + NB * CTX;
constexpr int SKV = LSEQ + CTX;
constexpr int NSTRIP = MALL / 64;
constexpr float MAX_DECAY = -15.350567286626973f, MIN_DECAY = -3.0701134573253945f;
constexpr float EPSN = 1e-6f;
constexpr int NTHR = 512;

constexpr size_t MiB = 1u << 20;
constexpr size_t WS_CTL = 0, CTL_ZERO_BYTES = 16384;
constexpr size_t WS_MOD = 1 * MiB;
constexpr size_t WS_H3 = 2 * MiB;
constexpr size_t WS_H3C = 4 * MiB;
constexpr size_t WS_ROPE = 5 * MiB;
constexpr size_t WS_KTC = 6 * MiB;
constexpr size_t WS_X1C = 10 * MiB;
constexpr size_t WS_WIN = 12 * MiB;
constexpr size_t WS_WOUT = 28 * MiB;
constexpr size_t WS_AWIN = 32 * MiB;
constexpr size_t WS_AWOUT = 42 * MiB;
constexpr size_t WS_H = 46 * MiB;
constexpr size_t WS_S = 79 * MiB;
constexpr size_t WS_UT = 112 * MiB;
constexpr size_t WS_G = 178 * MiB;
constexpr size_t WS_Q = 112 * MiB;
constexpr size_t WS_ZS = 176 * MiB;
constexpr size_t WS_KB = 79 * MiB;
constexpr size_t WS_VB = WS_KB + (size_t)NB * 4 * SKV * 128 * 2;
constexpr size_t WS_H3X = 244 * MiB;
constexpr size_t WS_W4X = 249 * MiB;
constexpr size_t WS_END = 252 * MiB;
static_assert(WS_VB + (size_t)NB * 4 * SKV * 128 * 2 <= WS_Q, "kv map");
static_assert(WS_ZS + (size_t)MLAT * 2048 * 2 <= WS_END, "zs map");

constexpr int LDS_BYTES = 163840;
constexpr int LDS_XCH = 131072;
constexpr int LDS_MISC = LDS_BYTES - 64;

__device__ __forceinline__ unsigned pk2(float lo, float hi) { unsigned r; asm("v_cvt_pk_bf16_f32 %0, %1, %2" : "=v"(r) : "v"(lo), "v"(hi)); return r; }
__device__ __forceinline__ unsigned f2bf(float f) { return pk2(f, f) & 0xffffu; }
__device__ __forceinline__ float bf2f(unsigned short h) { return __builtin_bit_cast(float, (unsigned)h << 16); }
__device__ __forceinline__ float silu_f(float z) { return z * __builtin_amdgcn_rcpf(1.f + __builtin_amdgcn_exp2f(-1.4426950408889634f * z)); }
__device__ __forceinline__ float wave_sum(float v) {
#pragma unroll
    for (int o = 1; o < 64; o <<= 1) v += __shfl_xor(v, o);
    return v;
}
namespace pg8 {
#define PG8_LAS __attribute__((address_space(3)))
typedef short bf16x8 __attribute__((ext_vector_type(8)));
constexpr int BM = 256, BK = 64, HALF = 128, HTB = HALF * BK * 2  , STAGE_BYTES = 8 * HTB, NXCD = 8, WGM = 8;

__host__ __device__ __forceinline__ int lds_byte(int r, int c) { const int st = (r >> 4) * 2 + (c >> 5), rr = r & 15, cc = c & 31, ob = rr * 64 + cc * 2; return st * 1024 + (ob ^ (((ob >> 9) & 1) << 5)); }
__host__ __device__ __forceinline__ void stage_rc(int b, int& R, int& C) { const int st = b / 1024, sb = b % 1024, swz = sb ^ (((sb >> 9) & 1) << 5); R = (st >> 1) * 16 + swz / 64; C = (st & 1) * 32 + (swz % 64) / 2; }
__host__ __device__ __forceinline__ int perm32(int rho) { const int n = rho >> 4, i = rho & 15; return 8 * (i >> 2) + 4 * n + (i & 3); }

struct Unit { int pm, pn, k0, nt; };
struct Gemm { const bf16_t* A; const bf16_t* Bt; int M, N, K; };
struct StaticOrder {
    int nM, nN, nwg, G, c, knt;
    __host__ __device__ void init(int M, int N, int G_, int c_, int K_) { nM = M / BM; nN = N / BM; nwg = nM * nN; G = G_; c = c_; knt = K_ / BK; }
    __host__ __device__ bool next(int i, Unit& u) const {
        const long L = (long)i * G + c; if (L >= nwg) return false;
        int wgid = (int)L; { const int q = nwg / NXCD, r = nwg % NXCD, xcd = wgid % NXCD, off = wgid / NXCD; wgid = (xcd < r ? xcd * (q + 1) : r * (q + 1) + (xcd - r) * q) + off; }
        const int nig = WGM * nN, gid = wgid / nig, fm = gid * WGM, gsz = (nM - fm) < WGM ? (nM - fm) : WGM;
        u.pm = fm + ((wgid % nig) % gsz); u.pn = (wgid % nig) / gsz; u.k0 = 0; u.nt = knt; return true;
    }
    __device__ __forceinline__ void a_ready(const Unit&) const {}
    __device__ __forceinline__ void done(const Unit&) const {}
};
__device__ __forceinline__ unsigned cvt_pk_bf16(float lo, float hi) { unsigned r; asm volatile("v_cvt_pk_bf16_f32 %0, %1, %2" : "=v"(r) : "v"(lo), "v"(hi)); return r; }
typedef float f32x2 __attribute__((ext_vector_type(2)));
__device__ __forceinline__ float dpp_ror1(float v) { return __builtin_bit_cast(float, __builtin_amdgcn_update_dpp(0, __builtin_bit_cast(int, v), 0x121, 0xf, 0xf, false)); }
__device__ __forceinline__ float dpp_ror15(float v) { return __builtin_bit_cast(float, __builtin_amdgcn_update_dpp(0, __builtin_bit_cast(int, v), 0x12f, 0xf, 0xf, false)); }
struct EpiHy {
    static constexpr bool PERM = true, AFTER_DRAIN = false;
    const float* cw; const float* cb; bf16_t* UT; bf16_t* G; float* S; PG8_LAS unsigned char* xl;
    __device__ __forceinline__ void operator()(const f32x4 (&acc)[2][2][4][2], const Unit& u, int wr, int wc, int fr, int fq) const {
        asm volatile("" : "+v"(fr), "+v"(fq));
        const int lane = fq * 16 + fr;
        const int c0 = u.pn * 64 + 16 * wc + 4 * fq;
        PG8_LAS unsigned char* T = xl + (wr * 4 + wc) * 4096;
        f32x4 w[3][3], bb[3];
#pragma unroll
        for (int s = 0; s < 3; ++s) { bb[s] = *(const f32x4*)(cb + s * 2048 + c0);
#pragma unroll
            for (int t = 0; t < 3; ++t) w[s][t] = *(const f32x4*)(cw + t * 6144 + s * 2048 + c0); }
#pragma unroll
        for (int ai = 0; ai < 2; ++ai) {
            const int strip = u.pm * 4 + ai * 2 + wr;
#pragma unroll
            for (int m = 0; m < 4; ++m) {
                f32x4 cv[3];
#pragma unroll
                for (int s = 0; s < 3; ++s) {
                    const f32x4 cur = acc[ai][s >> 1][m][s & 1];
                    const f32x4 up = acc[ai][s >> 1][m > 0 ? m - 1 : 0][s & 1];
                    const f32x4 dn = acc[ai][s >> 1][m < 3 ? m + 1 : 3][s & 1];
                    f32x4 pv, nx;
#pragma unroll
                    for (int j = 0; j < 4; ++j) { const float sp = (fr == 15) ? up[j] : cur[j], sn = (fr == 0) ? dn[j] : cur[j]; pv[j] = dpp_ror1(sp); nx[j] = dpp_ror15(sn); }
                    cv[s] = w[s][0] * pv + w[s][1] * cur + w[s][2] * nx + bb[s];
                }
                const f32x4 z = acc[ai][1][m][1];
                const int row = strip * 64 + 16 * m + fr;
                const f32x4 uu = cv[1] * cv[2];
                f32x4 g;
#pragma unroll
                for (int j = 0; j < 4; ++j) { g[j] = cv[0][j] * silu_f(z[j]); *(PG8_LAS bf16_t*)(T + (4 * fq + j) * 144 + (16 * m + fr) * 2) = (bf16_t)f2bf(uu[j]); }
                u32x2 gw; gw.x = pk2(g[0], g[1]); gw.y = pk2(g[2], g[3]);
                *(u32x2*)(G + (size_t)row * 2048 + c0) = gw;
                __builtin_amdgcn_sched_barrier(0);
            }
            {
                const int chn = lane >> 2, chunk = lane & 3;
                const u32x4 q0 = *(const PG8_LAS u32x4*)(T + chn * 144 + chunk * 32), q1 = *(const PG8_LAS u32x4*)(T + chn * 144 + chunk * 32 + 16);
                bf16_t* up_ = UT + (size_t)(u.pn * 64 + 16 * wc + chn) * MALL + strip * 64 + 16 * chunk;
                *(u32x4*)up_ = q0; *(u32x4*)(up_ + 8) = q1;
            }
            if (fr < 2) {
#pragma unroll
                for (int s = 0; s < 4; ++s) *(f32x4*)(S + ((size_t)((strip * 4 + fr) * 4 + s)) * 2048 + c0) = acc[ai][s >> 1][0][s & 1];
            }
            if (fr >= 14) {
#pragma unroll
                for (int s = 0; s < 4; ++s) *(f32x4*)(S + ((size_t)((strip * 4 + fr - 12) * 4 + s)) * 2048 + c0) = acc[ai][s >> 1][3][s & 1];
            }
        }
    }
};
struct EpiRes {
    static constexpr bool PERM = true, AFTER_DRAIN = false;
    const float* xlat; const float* xctx; float* olat; float* octx; const float* mod;
    __device__ __forceinline__ void operator()(const f32x4 (&acc)[2][2][4][2], const Unit& u, int wr, int wc, int fr, int fq) const {
        asm volatile("" : "+v"(fr), "+v"(fq));
        const int col0 = u.pn * 256 + wc * 32 + 8 * fq;
#pragma unroll
        for (int ai = 0; ai < 2; ++ai)
#pragma unroll
            for (int m = 0; m < 4; ++m) {
                const int row = u.pm * 256 + ai * 128 + wr * 64 + m * 16 + fr;
                const int src = row < LSEQ ? 0 : (row < MLAT ? 1 : 2);
                const float* xi; float* od;
                if (row < MLAT) { xi = xlat + (size_t)row * DM; od = olat + (size_t)row * DM; } else { xi = xctx + (size_t)(row - MLAT) * DM; od = octx + (size_t)(row - MLAT) * DM; }
                const float* gt = mod + src * 3072 + 2048;
#pragma unroll
                for (int bj = 0; bj < 2; ++bj) { const int col = col0 + bj * 128;
                    const f32x4 g0 = *(const f32x4*)(gt + col), g1 = *(const f32x4*)(gt + col + 4), x0 = *(const f32x4*)(xi + col), x1 = *(const f32x4*)(xi + col + 4);
                    *(f32x4*)(od + col) = x0 + g0 * acc[ai][bj][m][0]; *(f32x4*)(od + col + 4) = x1 + g1 * acc[ai][bj][m][1]; }
            }
    }
};
struct EpiQKV {
    static constexpr bool PERM = true, AFTER_DRAIN = false;
    const float* qg; const float* kg; const float* rope; bf16_t* Q; bf16_t* KB; bf16_t* VB; bf16_t* ZS; PG8_LAS float* xl;
    __device__ __forceinline__ void operator()(const f32x4 (&acc)[2][2][4][2], const Unit& u, int wr, int wc, int fr, int fq) const {
        asm volatile("" : "+v"(fr), "+v"(fq));
        const int pn = u.pn;
        if (pn < 10) {
            const bool isq = pn < 8;
#pragma unroll
            for (int ai = 0; ai < 2; ++ai)
#pragma unroll
                for (int m = 0; m < 4; ++m)
#pragma unroll
                    for (int bj = 0; bj < 2; ++bj) { const f32x4 a = acc[ai][bj][m][0], b = acc[ai][bj][m][1];
                        float s = (a[0] * a[0] + a[1] * a[1]) + (a[2] * a[2] + a[3] * a[3]) + (b[0] * b[0] + b[1] * b[1]) + (b[2] * b[2] + b[3] * b[3]);
                        s += __shfl_xor(s, 16); s += __shfl_xor(s, 32);
                        if (fq == 0) xl[((ai * 128 + wr * 64 + m * 16 + fr) * 2 + bj) * 4 + wc] = s; }
            asm volatile("s_waitcnt lgkmcnt(0)" ::: "memory"); __builtin_amdgcn_s_barrier(); asm volatile("" ::: "memory");
            const float* gg = isq ? qg : kg; const int d0 = 2 * (4 * wc + fq);
            float gv[2][4];
#pragma unroll
            for (int n = 0; n < 2; ++n)
#pragma unroll
                for (int j = 0; j < 4; ++j) gv[n][j] = gg[32 * (2 * n + (j >> 1)) + d0 + (j & 1)] * (isq ? 0.088388347648318440f * 1.4426950408889634f : 1.0f);
#pragma unroll
            for (int ai = 0; ai < 2; ++ai)
#pragma unroll
                for (int m = 0; m < 4; ++m) {
                    const int rl = ai * 128 + wr * 64 + m * 16 + fr, row = u.pm * 256 + rl;
                    const bool lat = row < MLAT; const int t = row & (LSEQ - 1);
                    const f32x4 rr = *(const f32x4*)(rope + ((t >> 6) * 32 + d0) * 2);
                    const f32x4 rc = *(const f32x4*)(rope + ((t & 63) * 32 + d0) * 2);
                    int bb_, ss_; if (lat) { bb_ = row >> 13; ss_ = t; } else { bb_ = (row - MLAT) >> 8; ss_ = LSEQ + ((row - MLAT) & 255); }
#pragma unroll
                    for (int bj = 0; bj < 2; ++bj) {
                        const f32x4 p4 = *(const PG8_LAS f32x4*)(xl + (rl * 2 + bj) * 4);
                        const float rinv = rsqrtf(((p4[0] + p4[1]) + (p4[2] + p4[3])) * (1.f / 128.f) + EPSN);
                        float y[2][4], o[2][4];
#pragma unroll
                        for (int n = 0; n < 2; ++n)
#pragma unroll
                            for (int j = 0; j < 4; ++j) y[n][j] = acc[ai][bj][m][n][j] * rinv * gv[n][j];
                        if (lat) {
#pragma unroll
                            for (int e = 0; e < 2; ++e) {
                                o[0][e] = y[0][e] * rr[2 * e] - y[0][2 + e] * rr[2 * e + 1]; o[0][2 + e] = y[0][e] * rr[2 * e + 1] + y[0][2 + e] * rr[2 * e];
                                o[1][e] = y[1][e] * rc[2 * e] - y[1][2 + e] * rc[2 * e + 1]; o[1][2 + e] = y[1][e] * rc[2 * e + 1] + y[1][2 + e] * rc[2 * e]; }
                        } else {
#pragma unroll
                            for (int n = 0; n < 2; ++n)
#pragma unroll
                                for (int j = 0; j < 4; ++j) o[n][j] = y[n][j];
                        }
                        u32x4 wv; wv.x = pk2(o[0][0], o[0][1]); wv.y = pk2(o[0][2], o[0][3]); wv.z = pk2(o[1][0], o[1][1]); wv.w = pk2(o[1][2], o[1][3]);
                        if (isq) { if (lat) *(u32x4*)(Q + (size_t)row * 2048 + (2 * pn + bj) * 128 + 32 * wc + 8 * fq) = wv; }
                        else { const int kvh = 2 * (pn - 8) + bj; *(u32x4*)(KB + ((size_t)(bb_ * 4 + kvh) * SKV + ss_) * 128 + 32 * wc + 8 * fq) = wv; }
                        __builtin_amdgcn_sched_barrier(0);
                    }
                }
        } else {
#pragma unroll
            for (int ai = 0; ai < 2; ++ai)
#pragma unroll
                for (int m = 0; m < 4; ++m) {
                    const int row = u.pm * 256 + ai * 128 + wr * 64 + m * 16 + fr;
                    const bool lat = row < MLAT; const int t = row & (LSEQ - 1);
                    int bb_, ss_; if (lat) { bb_ = row >> 13; ss_ = t; } else { bb_ = (row - MLAT) >> 8; ss_ = LSEQ + ((row - MLAT) & 255); }
#pragma unroll
                    for (int bj = 0; bj < 2; ++bj) {
                        f32x4 a = acc[ai][bj][m][0], b = acc[ai][bj][m][1];
                        if (pn < 12) {
                            u32x4 wv; wv.x = pk2(a[0], a[1]); wv.y = pk2(a[2], a[3]); wv.z = pk2(b[0], b[1]); wv.w = pk2(b[2], b[3]);
                            const int kvh = 2 * (pn - 10) + bj; *(u32x4*)(VB + ((size_t)(bb_ * 4 + kvh) * SKV + ss_) * 128 + 32 * wc + 8 * fq) = wv;
                        } else if (lat) {
#pragma unroll
                            for (int j = 0; j < 4; ++j) { a[j] = silu_f(a[j]); b[j] = silu_f(b[j]); }
                            u32x4 wv; wv.x = pk2(a[0], a[1]); wv.y = pk2(a[2], a[3]); wv.z = pk2(b[0], b[1]); wv.w = pk2(b[2], b[3]);
                            *(u32x4*)(ZS + (size_t)row * 2048 + (pn - 12) * 256 + bj * 128 + 32 * wc + 8 * fq) = wv;
                        }
                    }
                }
        }
    }
};

struct EpiKgen {
    static constexpr bool PERM = true, AFTER_DRAIN = false;
    bf16_t* KT; float* KTC;
    __device__ __forceinline__ void operator()(const f32x4 (&acc)[2][2][4][2], const Unit& u, int wr, int wc, int fr, int fq) const {
        asm volatile("" : "+v"(fr), "+v"(fq));
#pragma unroll
        for (int ai = 0; ai < 2; ++ai)
#pragma unroll
            for (int m = 0; m < 4; ++m) {
                const int n = u.pm * 256 + ai * 128 + wr * 64 + m * 16 + fr, dir = n >> 11, ch = n & 2047;
                const float delta = fabsf(MIN_DECAY + (float)ch * ((MAX_DECAY - MIN_DECAY) / 2047.0f));
#pragma unroll
                for (int bj = 0; bj < 2; ++bj) {
                    const int t0 = u.pn * 256 + bj * 128 + wc * 32 + 8 * fq;
                    const bool lat = u.pn < 32; const int tb = lat ? t0 : t0 - LSEQ; const float rl = lat ? (1.0f / 8191.0f) : (1.0f / 255.0f);
                    float v[8];
#pragma unroll
                    for (int e = 0; e < 8; ++e) v[e] = acc[ai][bj][m][e >> 2][e & 3] * __expf(-(float)(tb + e) * rl * delta);
                    if (lat) { u32x4 w; w.x = pk2(v[0], v[1]); w.y = pk2(v[2], v[3]); w.z = pk2(v[4], v[5]); w.w = pk2(v[6], v[7]); *(u32x4*)(KT + (size_t)(ch * 2 + dir) * LSEQ + tb) = w; }
                    else { float* kp = KTC + (size_t)(ch * 2 + dir) * 256 + tb; *(f32x4*)kp = (f32x4){v[0], v[1], v[2], v[3]}; *(f32x4*)(kp + 4) = (f32x4){v[4], v[5], v[6], v[7]}; }
                }
            }
    }
};

struct OrderP6 {
    StaticOrder so; int c;
    __host__ __device__ void init(int G_, int c_) { so.init(MLAT, 1024, G_, c_, 2048); c = c_; }
    __host__ __device__ bool next(int i, Unit& u) const {
        const int G = so.G, nl = c < 256 ? (256 - c + G - 1) / G : 0;
        if (i < nl) return so.next(i, u);
        const int s = (i - nl) * G + c;
        if (s < 64) { u.pm = 64 + (s >> 5); u.pn = (s >> 3) & 3; u.k0 = (s & 7) * 256; u.nt = 4; return true; }
        return false;
    }
    __device__ __forceinline__ void a_ready(const Unit&) const {}
    __device__ __forceinline__ void done(const Unit&) const {}
};
struct EpiRes6 {
    static constexpr bool PERM = true, AFTER_DRAIN = false;
    const float* xlat; float* olat; const float* mod; float* PART;
    __device__ __forceinline__ void operator()(const f32x4 (&acc)[2][2][4][2], const Unit& u, int wr, int wc, int fr, int fq) const {
        asm volatile("" : "+v"(fr), "+v"(fq));
        const int col0 = u.pn * 256 + wc * 32 + 8 * fq;
#pragma unroll
        for (int ai = 0; ai < 2; ++ai)
#pragma unroll
            for (int m = 0; m < 4; ++m) {
                const int row = u.pm * 256 + ai * 128 + wr * 64 + m * 16 + fr;
                if (u.pm < 64) {
                    const float* xi = xlat + (size_t)row * DM; float* od = olat + (size_t)row * DM; const float* gt = mod + (row < LSEQ ? 0 : 1) * 3072 + 2048;
#pragma unroll
                    for (int bj = 0; bj < 2; ++bj) { const int col = col0 + bj * 128;
                        const f32x4 g0 = *(const f32x4*)(gt + col), g1 = *(const f32x4*)(gt + col + 4), x0 = *(const f32x4*)(xi + col), x1 = *(const f32x4*)(xi + col + 4);
                        *(f32x4*)(od + col) = x0 + g0 * acc[ai][bj][m][0]; *(f32x4*)(od + col + 4) = x1 + g1 * acc[ai][bj][m][1]; }
                } else {
                    float* pp = PART + ((size_t)(u.k0 >> 8) * 512 + (row - MLAT)) * DM;
#pragma unroll
                    for (int bj = 0; bj < 2; ++bj) { const int col = col0 + bj * 128; *(f32x4*)(pp + col) = acc[ai][bj][m][0]; *(f32x4*)(pp + col + 4) = acc[ai][bj][m][1]; }
                }
            }
    }
};
template <class Epi, class Sched, bool ALIGN_EPI = false, bool SP2 = false>
__device__ __forceinline__ void gemm_phase(PG8_LAS unsigned char* lds, const Gemm g, const Sched& S, const Epi& E, int tid_) {
    asm volatile("" : "+v"(tid_));
    const int tid = tid_, wid = __builtin_amdgcn_readfirstlane(tid >> 6), lane = tid & 63, wr = wid >> 2, wc = wid & 3, fr = lane & 15, fq = lane >> 4;
    const int K = g.K;
    unsigned voffA[2], voffB[2];
#pragma unroll
    for (int i = 0; i < 2; ++i) { int R, C; stage_rc(tid * 16 + i * 8192, R, C); const int Rb = Epi::PERM ? ((R & ~31) + perm32(R & 31)) : R;
        voffA[i] = (unsigned)(R * K + C) * 2u; voffB[i] = (unsigned)(Rb * K + C) * 2u; }
    const size_t kstep = (size_t)(BK * 2);
    const size_t hstep = (size_t)HALF * K * 2;
    const size_t tstep = 2 * hstep;
    const unsigned ldsw = (unsigned)wid * 1024u;
    const int aoff = lds_byte(wr * 64 + fr, fq * 8), boff = lds_byte(wc * 32 + fr, fq * 8);
#define PG8_SA(b, h) (((b) * 2 + (h)) * HTB)
#define PG8_SB(b, h) ((4 + (b) * 2 + (h)) * HTB)
#define PG8_STAGE(bufoff, gbase, voff) do { _Pragma("unroll") for (int _i = 0; _i < 2; ++_i) \
        __builtin_amdgcn_global_load_lds((const unsigned*)((const char*)(gbase) + (voff)[_i]), (PG8_LAS unsigned*)(lds + (bufoff) + ldsw + _i * 8192), 16, 0, 0); } while (0)
#define PG8_LDA(dst, b, h) do { _Pragma("unroll") for (int m = 0; m < 4; ++m) _Pragma("unroll") for (int k = 0; k < 2; ++k) dst[m][k] = *(const PG8_LAS bf16x8*)(lds + PG8_SA(b, h) + aoff + m * 2048 + k * 1024); } while (0)
#define PG8_LDB(dst, b, h) do { _Pragma("unroll") for (int n = 0; n < 2; ++n) _Pragma("unroll") for (int k = 0; k < 2; ++k) dst[n][k] = *(const PG8_LAS bf16x8*)(lds + PG8_SB(b, h) + boff + n * 2048 + k * 1024); } while (0)
#define PG8_MMA(ai, bj, At, Bt) do { __builtin_amdgcn_s_setprio(1); _Pragma("unroll") for (int m = 0; m < 4; ++m) _Pragma("unroll") for (int n = 0; n < 2; ++n) _Pragma("unroll") for (int k = 0; k < 2; ++k) \
        acc[ai][bj][m][n] = __builtin_amdgcn_mfma_f32_16x16x32_bf16(Bt[n][k], At[m][k], acc[ai][bj][m][n], 0, 0, 0); __builtin_amdgcn_s_setprio(0); } while (0)
#define PG8_WAIT_V(n) asm volatile("s_waitcnt vmcnt(" #n ")" ::: "memory")
#define PG8_WAIT_L(n) asm volatile("s_waitcnt lgkmcnt(" #n ")" ::: "memory")
#define PG8_BAR __builtin_amdgcn_s_barrier()
#define PG8_SCHED __builtin_amdgcn_sched_barrier(0)
    Unit cur, nxt; int ui = 0;
    if (!S.next(0, cur)) return;
    f32x4 acc[2][2][4][2];
#pragma unroll
    for (int a = 0; a < 2; ++a)
#pragma unroll
        for (int b = 0; b < 2; ++b)
#pragma unroll
            for (int m = 0; m < 4; ++m)
#pragma unroll
                for (int n = 0; n < 2; ++n) acc[a][b][m][n] = (f32x4){0.f, 0.f, 0.f, 0.f};
    bf16x8 At[4][2], B0[2][2], B1[2][2];
    const char* cA = (const char*)g.A + (size_t)cur.pm * tstep + (size_t)cur.k0 * 2; const char* cB = (const char*)g.Bt + (size_t)cur.pn * tstep + (size_t)cur.k0 * 2;
    S.a_ready(cur);
    if constexpr (SP2) {
        PG8_STAGE(PG8_SB(0, 0), cB, voffB); PG8_STAGE(PG8_SB(0, 1), cB + hstep, voffB); PG8_STAGE(PG8_SA(0, 0), cA, voffA); PG8_STAGE(PG8_SA(0, 1), cA + hstep, voffA);
        if (wr == 1) PG8_BAR;
        PG8_WAIT_V(2); PG8_BAR;
        PG8_STAGE(PG8_SB(1, 0), cB + kstep, voffB); PG8_STAGE(PG8_SA(1, 0), cA + kstep, voffA); PG8_STAGE(PG8_SB(1, 1), cB + hstep + kstep, voffB);
        PG8_WAIT_V(6); PG8_BAR;
    } else {
        PG8_STAGE(PG8_SB(0, 0), cB, voffB); PG8_STAGE(PG8_SA(0, 0), cA, voffA); PG8_STAGE(PG8_SB(0, 1), cB + hstep, voffB); PG8_STAGE(PG8_SA(0, 1), cA + hstep, voffA);
        if (wr == 1) PG8_BAR;
        PG8_WAIT_V(4); PG8_BAR;
        PG8_STAGE(PG8_SB(1, 0), cB + kstep, voffB); PG8_STAGE(PG8_SA(1, 0), cA + kstep, voffA); PG8_STAGE(PG8_SB(1, 1), cB + hstep + kstep, voffB);
        PG8_WAIT_V(6); PG8_BAR;
    }
    for (;;) {
        const bool has_next = S.next(ui + 1, nxt);
        const char* nA = has_next ? (const char*)g.A + (size_t)nxt.pm * tstep + (size_t)nxt.k0 * 2 : cA; const char* nB = has_next ? (const char*)g.Bt + (size_t)nxt.pn * tstep + (size_t)nxt.k0 * 2 : cB;
        const int nt = cur.nt;
        for (int t = 0; t < nt; t += 2) {
            const bool last = (t == nt - 2);
            const char* a1 = cA + (size_t)(t + 1) * kstep;
            const char* a2 = last ? nA : cA + (size_t)(t + 2) * kstep; const char* b2 = last ? nB : cB + (size_t)(t + 2) * kstep;
            const char* a3 = a2 + kstep; const char* b3 = b2 + kstep;
            if (last && has_next) S.a_ready(nxt);
            if constexpr (SP2) {
            PG8_LDB(B0, 0, 0); PG8_LDB(B1, 0, 1); PG8_SCHED; PG8_LDA(At, 0, 0); PG8_STAGE(PG8_SA(1, 1), a1 + hstep, voffA);
            PG8_WAIT_V(8); PG8_WAIT_L(0); PG8_BAR; PG8_MMA(0, 0, At, B0); PG8_MMA(0, 1, At, B1); PG8_BAR; PG8_SCHED;
            PG8_LDA(At, 0, 1); PG8_STAGE(PG8_SB(0, 0), b2, voffB); PG8_STAGE(PG8_SB(0, 1), b2 + hstep, voffB); PG8_STAGE(PG8_SA(0, 0), a2, voffA);
            PG8_WAIT_V(8); PG8_WAIT_L(0); PG8_BAR; PG8_MMA(1, 0, At, B0); PG8_MMA(1, 1, At, B1); PG8_BAR; PG8_SCHED;
            PG8_LDB(B0, 1, 0); PG8_LDB(B1, 1, 1); PG8_SCHED; PG8_LDA(At, 1, 0); PG8_STAGE(PG8_SA(0, 1), a2 + hstep, voffA);
            PG8_WAIT_V(8); PG8_WAIT_L(0); PG8_BAR; PG8_MMA(0, 0, At, B0); PG8_MMA(0, 1, At, B1); PG8_BAR; PG8_SCHED;
            PG8_LDA(At, 1, 1); PG8_STAGE(PG8_SB(1, 0), b3, voffB); PG8_STAGE(PG8_SB(1, 1), b3 + hstep, voffB); PG8_STAGE(PG8_SA(1, 0), a3, voffA);
            PG8_WAIT_V(8); PG8_WAIT_L(0); PG8_BAR; PG8_MMA(1, 0, At, B0); PG8_MMA(1, 1, At, B1); PG8_BAR; PG8_SCHED;
            } else {
            PG8_LDB(B0, 0, 0); PG8_SCHED; PG8_LDA(At, 0, 0); PG8_STAGE(PG8_SA(1, 1), a1 + hstep, voffA);
            PG8_WAIT_L(8); PG8_BAR; PG8_WAIT_L(0); PG8_MMA(0, 0, At, B0); PG8_BAR; PG8_SCHED;
            PG8_LDB(B1, 0, 1); PG8_STAGE(PG8_SB(0, 0), b2, voffB);
            PG8_BAR; PG8_WAIT_L(0); PG8_MMA(0, 1, At, B1); PG8_BAR;
            PG8_LDA(At, 0, 1); PG8_STAGE(PG8_SA(0, 0), a2, voffA);
            PG8_BAR; PG8_WAIT_L(0); PG8_MMA(1, 0, At, B0); PG8_BAR; PG8_SCHED;
            PG8_STAGE(PG8_SB(0, 1), b2 + hstep, voffB);
            PG8_WAIT_V(6); PG8_BAR; PG8_MMA(1, 1, At, B1); PG8_BAR;
            PG8_LDB(B0, 1, 0); PG8_SCHED; PG8_LDA(At, 1, 0); PG8_STAGE(PG8_SA(0, 1), a2 + hstep, voffA);
            PG8_WAIT_L(8); PG8_BAR; PG8_WAIT_L(0); PG8_MMA(0, 0, At, B0); PG8_BAR; PG8_SCHED;
            PG8_LDB(B1, 1, 1); PG8_STAGE(PG8_SB(1, 0), b3, voffB);
            PG8_BAR; PG8_WAIT_L(0); PG8_MMA(0, 1, At, B1); PG8_BAR;
            PG8_LDA(At, 1, 1); PG8_STAGE(PG8_SA(1, 0), a3, voffA);
            PG8_BAR; PG8_WAIT_L(0); PG8_MMA(1, 0, At, B0); PG8_BAR; PG8_SCHED;
            PG8_STAGE(PG8_SB(1, 1), b3 + hstep, voffB);
            PG8_WAIT_V(6); PG8_BAR; PG8_MMA(1, 1, At, B1); PG8_BAR;
            }
        }
        if constexpr (ALIGN_EPI) { if (wr == 0) PG8_BAR; }
        if constexpr (!Epi::AFTER_DRAIN) { E(acc, cur, wr, wc, fr, fq); S.done(cur); }
        if (!has_next) break;
#pragma unroll
        for (int a = 0; a < 2; ++a)
#pragma unroll
            for (int b = 0; b < 2; ++b)
#pragma unroll
                for (int m = 0; m < 4; ++m)
#pragma unroll
                    for (int n = 0; n < 2; ++n) acc[a][b][m][n] = (f32x4){0.f, 0.f, 0.f, 0.f};
        cur = nxt; cA = nA; cB = nB; ++ui;
        if constexpr (ALIGN_EPI) { if (wr == 1) PG8_BAR; }
    }
    PG8_WAIT_V(0);
    if constexpr (!ALIGN_EPI) { if (wr == 0) PG8_BAR; }
    PG8_BAR;
    if constexpr (Epi::AFTER_DRAIN) { E.fused(acc, cur, wr, wc, fr, fq, lds, wid, lane); S.done(cur); }
#undef PG8_SA
#undef PG8_SB
#undef PG8_STAGE
#undef PG8_LDA
#undef PG8_LDB
#undef PG8_MMA
#undef PG8_WAIT_V
#undef PG8_WAIT_L
#undef PG8_BAR
#undef PG8_SCHED
}
}
namespace att {
typedef unsigned short bf16;
constexpr int   D = 128, NW = 8, QBLK = 32, KVBLK = 64;
constexpr float SCALE = 0.088388347648318440f;
constexpr float THR = 8.f;
constexpr int SDEPTH = 2;
constexpr int LDQ = 2048, LDK = 128, LDO = 2048;
constexpr size_t SHM_V = KVBLK * D * 2, SHM_K = KVBLK * D * 2, SHM_ATTN = 3 * SHM_V + 3 * SHM_K + NW * 64 * 4;
using bf16x8 = __attribute__((ext_vector_type(8))) short;
using s16x4  = __attribute__((ext_vector_type(4))) short;
using f32x16 = __attribute__((ext_vector_type(16))) float;
using f32x8  = __attribute__((ext_vector_type(8))) float;
using u32x4  = __attribute__((ext_vector_type(4))) unsigned;
#define KSWZ(row, colB) ((row) * 256 + ((colB) ^ (((row) & 7) << 4)))
#define SBAR() __builtin_amdgcn_sched_barrier(0)
__device__ __forceinline__ int crow(int r, int hi) { return (r & 3) + 8 * (r >> 2) + 4 * hi; }
__device__ __forceinline__ unsigned cvtpk(float lo, float hi) {
  unsigned r; asm volatile("v_cvt_pk_bf16_f32 %0, %1, %2" : "=v"(r) : "v"(lo), "v"(hi)); return r;
}
template <typename TIn> struct Stage;
template <> struct Stage<bf16>  { using T = bf16x8;
  __device__ static __forceinline__ T ld8(const bf16* p) { return *reinterpret_cast<const bf16x8*>(p); }
  __device__ static __forceinline__ bf16x8 tobf(T x) { return x; } };
template <bool SHIFT> __device__ __forceinline__ void partialSMF(f32x16& p0, f32x16& p1, float mnC) {
  if (SHIFT) { for (int r = 0; r < 16; ++r) p0[r] += mnC; for (int r = 0; r < 16; ++r) p1[r] += mnC; }
  for (int r = 0; r < 16; ++r) p0[r] = __builtin_amdgcn_exp2f(p0[r]);
}
__device__ __forceinline__ void partialSM(f32x16& p0, f32x16& p1, float& m_reg, float& mn, float& alpha) {
  constexpr float C = SCALE * 1.4426950408889634f;
  float pmax = p0[0]; for (int r = 1; r < 16; ++r) pmax = fmaxf(pmax, p0[r]); for (int r = 0; r < 16; ++r) pmax = fmaxf(pmax, p1[r]);
  { auto rr = __builtin_amdgcn_permlane32_swap(__float_as_uint(pmax), __float_as_uint(pmax), false, false);
    pmax = fmaxf(__uint_as_float(rr[0]), __uint_as_float(rr[1])); }
  if (__builtin_expect(__all(pmax - m_reg <= THR / SCALE), 1)) { mn = m_reg; alpha = 1.f; }
  else { mn = fmaxf(m_reg, pmax); alpha = __builtin_amdgcn_exp2f((m_reg - mn) * C); m_reg = mn; }
  float mnC = -mn * C;
  for (int r = 0; r < 16; ++r) p0[r] = fmaf(p0[r], C, mnC); for (int r = 0; r < 16; ++r) p1[r] = fmaf(p1[r], C, mnC);
  for (int r = 0; r < 16; ++r) p0[r] = __builtin_amdgcn_exp2f(p0[r]);
}
__device__ __forceinline__ void finishSM(f32x16& p0, f32x16& p1, float alpha, float& l_reg, bf16x8& pa0, bf16x8& pa1, bf16x8& pa2, bf16x8& pa3) {
  for (int r = 0; r < 16; ++r) p1[r] = __builtin_amdgcn_exp2f(p1[r]);
  float ps = 0; for (int r = 0; r < 16; ++r) ps += p0[r]; for (int r = 0; r < 16; ++r) ps += p1[r];
  { auto rr = __builtin_amdgcn_permlane32_swap(__float_as_uint(ps), __float_as_uint(ps), false, false);
    ps = __uint_as_float(rr[0]) + __uint_as_float(rr[1]); }
  l_reg = l_reg * alpha + ps;
#define PK4(P, BASE, OUT) do { unsigned a0 = cvtpk(P[BASE + 0], P[BASE + 1]), a1 = cvtpk(P[BASE + 2], P[BASE + 3]);   \
    unsigned b0 = cvtpk(P[BASE + 4], P[BASE + 5]), b1 = cvtpk(P[BASE + 6], P[BASE + 7]);                              \
    auto r0 = __builtin_amdgcn_permlane32_swap(a0, b0, false, false); auto r1 = __builtin_amdgcn_permlane32_swap(a1, b1, false, false); \
    u32x4 w = {r0[0], r1[0], r0[1], r1[1]}; OUT = *reinterpret_cast<bf16x8*>(&w); } while (0)
  PK4(p0, 0, pa0); PK4(p0, 8, pa1); PK4(p1, 0, pa2); PK4(p1, 8, pa3);
#undef PK4
}
__device__ __forceinline__ void qkt(f32x16& p0, f32x16& p1, const bf16* Ks, const bf16x8* qr, int r32, int hi) {
  p0 = f32x16{}; p1 = f32x16{};
  for (int d0 = 0; d0 < 8; ++d0) { int cb = (d0 * 16 + hi * 8) * 2;
    bf16x8 b0 = *reinterpret_cast<const bf16x8*>((const char*)Ks + KSWZ(r32, cb));
    bf16x8 b1 = *reinterpret_cast<const bf16x8*>((const char*)Ks + KSWZ(32 + r32, cb));
    p0 = __builtin_amdgcn_mfma_f32_32x32x16_bf16(b0, qr[d0], p0, 0, 0, 0);
    p1 = __builtin_amdgcn_mfma_f32_32x32x16_bf16(b1, qr[d0], p1, 0, 0, 0); }
}
__device__ __forceinline__ int v_st(int k, int c) { const int kk = (k & ~0xC) | ((k & 4) << 1) | ((k & 8) >> 1); return ((kk >> 3) * 4 + (c >> 5)) * 512 + ((kk & 7) * 32 + (c & 31)) * 2; }
__device__ __forceinline__ int v_rd_base(int lane) { return ((lane & 3) << 3) | (((lane >> 2) & 3) << 6) | (((lane >> 4) & 1) << 5) | (((lane >> 5) & 1) << 8); }
constexpr int v_rd_off(int d0, int ks, int half) { return d0 * 512 + ks * 4096 + half * 2048; }
template <int OFF> __device__ __forceinline__ s16x4 tr_read(int vb) {
  s16x4 r; asm volatile("ds_read_b64_tr_b16 %0, %1 offset:%2" : "=&v"(r) : "v"(vb), "i"(OFF) : "memory"); return r;
}
template <int D0> __device__ __forceinline__ void pv_one(f32x16& od, int vb, bf16x8 pa0, bf16x8 pa1, bf16x8 pa2, bf16x8 pa3) {
  const s16x4 l0 = tr_read<v_rd_off(D0, 0, 0)>(vb), h0 = tr_read<v_rd_off(D0, 0, 1)>(vb), l1 = tr_read<v_rd_off(D0, 1, 0)>(vb), h1 = tr_read<v_rd_off(D0, 1, 1)>(vb);
  const s16x4 l2 = tr_read<v_rd_off(D0, 2, 0)>(vb), h2 = tr_read<v_rd_off(D0, 2, 1)>(vb), l3 = tr_read<v_rd_off(D0, 3, 0)>(vb), h3 = tr_read<v_rd_off(D0, 3, 1)>(vb);
  asm volatile("s_waitcnt lgkmcnt(0)" ::: "memory"); SBAR();
#define PK(L, H) (bf16x8){L[0], L[1], L[2], L[3], H[0], H[1], H[2], H[3]}
  od = __builtin_amdgcn_mfma_f32_32x32x16_bf16(pa0, PK(l0, h0), od, 0, 0, 0);
  od = __builtin_amdgcn_mfma_f32_32x32x16_bf16(pa1, PK(l1, h1), od, 0, 0, 0);
  od = __builtin_amdgcn_mfma_f32_32x32x16_bf16(pa2, PK(l2, h2), od, 0, 0, 0);
  od = __builtin_amdgcn_mfma_f32_32x32x16_bf16(pa3, PK(l3, h3), od, 0, 0, 0);
#undef PK
}
struct VFrag { s16x4 l0, h0, l1, h1, l2, h2, l3, h3; };
template <int D0> __device__ __forceinline__ void vfrag_load(VFrag& f, int vb) {
  f.l0 = tr_read<v_rd_off(D0, 0, 0)>(vb); f.h0 = tr_read<v_rd_off(D0, 0, 1)>(vb); f.l1 = tr_read<v_rd_off(D0, 1, 0)>(vb); f.h1 = tr_read<v_rd_off(D0, 1, 1)>(vb);
  f.l2 = tr_read<v_rd_off(D0, 2, 0)>(vb); f.h2 = tr_read<v_rd_off(D0, 2, 1)>(vb); f.l3 = tr_read<v_rd_off(D0, 3, 0)>(vb); f.h3 = tr_read<v_rd_off(D0, 3, 1)>(vb);
}
__device__ __forceinline__ void vfrag_mma(f32x16& od, const VFrag& f, bf16x8 pa0, bf16x8 pa1, bf16x8 pa2, bf16x8 pa3) {
#define PK(L, H) (bf16x8){L[0], L[1], L[2], L[3], H[0], H[1], H[2], H[3]}
  od = __builtin_amdgcn_mfma_f32_32x32x16_bf16(pa0, PK(f.l0, f.h0), od, 0, 0, 0);
  od = __builtin_amdgcn_mfma_f32_32x32x16_bf16(pa1, PK(f.l1, f.h1), od, 0, 0, 0);
  od = __builtin_amdgcn_mfma_f32_32x32x16_bf16(pa2, PK(f.l2, f.h2), od, 0, 0, 0);
  od = __builtin_amdgcn_mfma_f32_32x32x16_bf16(pa3, PK(f.l3, f.h3), od, 0, 0, 0);
#undef PK
}
__device__ __forceinline__ void pv_d0(f32x16* o, int vb, bf16x8 pa0, bf16x8 pa1, bf16x8 pa2, bf16x8 pa3) {
  VFrag a, b;
  vfrag_load<0>(a, vb); vfrag_load<1>(b, vb);
  asm volatile("s_waitcnt lgkmcnt(8)" ::: "memory"); SBAR(); vfrag_mma(o[0], a, pa0, pa1, pa2, pa3);
  vfrag_load<2>(a, vb);
  asm volatile("s_waitcnt lgkmcnt(8)" ::: "memory"); SBAR(); vfrag_mma(o[1], b, pa0, pa1, pa2, pa3);
  vfrag_load<3>(b, vb);
  asm volatile("s_waitcnt lgkmcnt(8)" ::: "memory"); SBAR(); vfrag_mma(o[2], a, pa0, pa1, pa2, pa3);
  asm volatile("s_waitcnt lgkmcnt(0)" ::: "memory"); SBAR(); vfrag_mma(o[3], b, pa0, pa1, pa2, pa3);
}
template <typename TQ, bool SHIFT>
__device__ __forceinline__ void attn_dense_body(const TQ* __restrict__ Qb, const bf16* __restrict__ Kh, const bf16* __restrict__ Vh,
                                                bf16* ZSb, int seq, char* lds, int tid_, int dry, float mnC) {
  constexpr int SDEPTH = SHIFT ? 1 : 2;
  using St = Stage<bf16>; using SQ = Stage<TQ>;
  asm volatile("" : "+v"(tid_));
  const int tid = tid_, wid = __builtin_amdgcn_readfirstlane(tid >> 6), lane0 = tid & 63, r32q = lane0 & 31, hiq = lane0 >> 5;
  bf16* V_lds = (bf16*)lds; bf16* K_lds = (bf16*)(lds + 3 * SHM_V);
  float* ws = (float*)(lds + 3 * SHM_V + 3 * SHM_K) + wid * 64; float* li_l = ws; float* al_l = ws + 32;
  float l_reg = 0; f32x16 o[4] = {}; bf16x8 qr[8];
  const TQ* Qw = Qb + (long)(wid * QBLK + r32q) * LDQ + hiq * 8;
#pragma unroll
  for (int d0 = 0; d0 < 8; ++d0) qr[d0] = SQ::tobf(SQ::ld8(Qw + d0 * 16));
  int lane; asm volatile("v_mbcnt_lo_u32_b32 %0, -1, 0\n\tv_mbcnt_hi_u32_b32 %0, -1, %0" : "=v"(lane));
  const int r32 = lane & 31, hi = lane >> 5;
  const int sr = tid >> 4, sc = (tid & 15) * 8, vst0 = v_st(sr, sc), vst1 = v_st(32 + sr, sc);
  const int vb0 = (int)(uintptr_t)V_lds + v_rd_base(lane);
  struct { typename St::T vs0, vs1, ks0, ks1; } sr_[SDEPTH];
#define SLOAD(i, k0) do { sr_[i].vs0 = St::ld8(&Vh[(long)((k0) + sr) * LDK + sc]); sr_[i].vs1 = St::ld8(&Vh[(long)((k0) + 32 + sr) * LDK + sc]); \
    sr_[i].ks0 = St::ld8(&Kh[(long)((k0) + sr) * LDK + sc]); sr_[i].ks1 = St::ld8(&Kh[(long)((k0) + 32 + sr) * LDK + sc]); } while (0)
#define SWRITE(b, i) do { *(bf16x8*)((char*)V_lds + (b) * SHM_V + vst0) = St::tobf(sr_[i].vs0);          \
    *(bf16x8*)((char*)V_lds + (b) * SHM_V + vst1) = St::tobf(sr_[i].vs1); int kc = sc * 2;               \
    *(bf16x8*)((char*)K_lds + (b) * SHM_K + KSWZ(sr, kc)) = St::tobf(sr_[i].ks0);                       \
    *(bf16x8*)((char*)K_lds + (b) * SHM_K + KSWZ(32 + sr, kc)) = St::tobf(sr_[i].ks1); } while (0)
#define SWAIT() do { if constexpr (SDEPTH == 2) asm volatile("s_waitcnt vmcnt(4)" ::: "memory"); else asm volatile("s_waitcnt vmcnt(0)" ::: "memory"); } while (0)
#define RESC(a) do { if (__any((a) < 1.f)) { if (hi == 0) al_l[r32] = (a); asm volatile("s_waitcnt lgkmcnt(0)" ::: "memory"); \
    for (int d = 0; d < 4; ++d) for (int r = 0; r < 16; ++r) o[d][r] *= al_l[crow(r, hi)]; } } while (0)
  f32x16 pA0, pA1, pB0, pB1; const float alA = 1.f, alB = 1.f; bf16x8 pa0, pa1, pa2, pa3; const int NT = seq / KVBLK;
  constexpr int SE = 0, SO = SDEPTH - 1;
  SLOAD(SE, 0); asm volatile("s_waitcnt vmcnt(0)" ::: "memory"); SWRITE(0, SE); __syncthreads();
  qkt(pA0, pA1, K_lds, qr, r32, hi); partialSMF<SHIFT>(pA0, pA1, mnC);
  SLOAD(SO, KVBLK); if constexpr (SDEPTH == 2) { if (2 < NT) SLOAD(SE, 2 * KVBLK); }
  SWAIT(); SWRITE(1, SO); __syncthreads();
  int cur = 1, prv = 0, nxt = 2;
  for (int j = 1; j + 1 < NT; j += 2) {
    SBAR(); qkt(pB0, pB1, (bf16*)((char*)K_lds + cur * (int)SHM_K), qr, r32, hi);
    finishSM(pA0, pA1, alA, l_reg, pa0, pa1, pa2, pa3); SBAR();
    SLOAD(SO, (j + SDEPTH) * KVBLK);
    pv_d0(o, vb0 + prv * (int)SHM_V, pa0, pa1, pa2, pa3); partialSMF<SHIFT>(pB0, pB1, mnC);
    SWAIT(); SWRITE(nxt, SE); __syncthreads();
    prv = cur; cur = nxt; nxt = (nxt == 2) ? 0 : nxt + 1;
    SBAR(); qkt(pA0, pA1, (bf16*)((char*)K_lds + cur * (int)SHM_K), qr, r32, hi);
    finishSM(pB0, pB1, alB, l_reg, pa0, pa1, pa2, pa3); SBAR();
    if (SDEPTH == 1 || j + 3 < NT) SLOAD(SE, (j + 1 + SDEPTH) * KVBLK);
    pv_d0(o, vb0 + prv * (int)SHM_V, pa0, pa1, pa2, pa3); partialSMF<SHIFT>(pA0, pA1, mnC);
    SWAIT(); SWRITE(nxt, SO); __syncthreads();
    prv = cur; cur = nxt; nxt = (nxt == 2) ? 0 : nxt + 1;
  }
  SBAR(); qkt(pB0, pB1, (bf16*)((char*)K_lds + cur * (int)SHM_K), qr, r32, hi);
  finishSM(pA0, pA1, alA, l_reg, pa0, pa1, pa2, pa3); SBAR();
  pv_d0(o, vb0 + prv * (int)SHM_V, pa0, pa1, pa2, pa3); partialSMF<SHIFT>(pB0, pB1, mnC);
  finishSM(pB0, pB1, alB, l_reg, pa0, pa1, pa2, pa3); SBAR();
  pv_d0(o, vb0 + cur * (int)SHM_V, pa0, pa1, pa2, pa3);
  if (hi == 0) li_l[r32] = l_reg; asm volatile("s_waitcnt lgkmcnt(0)" ::: "memory");
  float rli[16];
#pragma unroll
  for (int r = 0; r < 16; ++r) rli[r] = __builtin_amdgcn_rcpf(li_l[crow(r, hi)]);
  int le; asm volatile("v_mbcnt_lo_u32_b32 %0, -1, 0\n\tv_mbcnt_hi_u32_b32 %0, -1, %0" : "=v"(le));
  const int r32e = le & 31, hie = le >> 5;
  bf16* Zw = ZSb + (long)(wid * QBLK) * LDO;
#pragma unroll
  for (int r = 0; r < 16; ++r) { int orow = crow(r, hie);
    for (int d0 = 0; d0 < 4; ++d0) { bf16* zp = Zw + (long)orow * LDO + d0 * 32 + r32e; const float zs = __builtin_bit_cast(float, (unsigned)(*zp) << 16);
      const float a2 = o[d0][r] * rli[r] * zs; unsigned ub = __builtin_bit_cast(unsigned, a2); if (!dry) *zp = (bf16)((ub + 0x7fffu + ((ub >> 16) & 1u)) >> 16); } }
  __syncthreads();
#undef SLOAD
#undef SWRITE
#undef SWAIT
#undef RESC
}
}
#define XB_TMO      128
#define XB_XCNT(j)  (256  + 64 * (j))
#define XB_XSUB(j)  (1280 + 64 * (j))
#define XB_XGEN(j)  (2304 + 64 * (j))
#define XB_TOP      3328
#define XB_TOPGEN   3392
#define XCD_BAR_WORDS 3456
#define XB_SPIN_CAP (1u << 18)

__device__ __forceinline__ unsigned xb_ld(unsigned* p)              { return __hip_atomic_load(p, __ATOMIC_RELAXED, __HIP_MEMORY_SCOPE_AGENT); }
__device__ __forceinline__ unsigned xb_add(unsigned* p, unsigned v) { return __hip_atomic_fetch_add(p, v, __ATOMIC_RELAXED, __HIP_MEMORY_SCOPE_AGENT); }
__device__ __forceinline__ unsigned xb_xcc_id() { return (unsigned)__builtin_amdgcn_s_getreg((3 << 11) | 20) & 0xFu; }
#define XB_SPIN(cond, bar) do { unsigned _sp = 0; while (cond) { __builtin_amdgcn_s_sleep(1); \
    if ((++_sp & 255u) == 0u) { if (xb_ld(&(bar)[XB_TMO])) break; if (_sp > XB_SPIN_CAP) { atomicAdd(&(bar)[XB_TMO], 1u); break; } } } } while (0)

struct XcdBarrier {
    unsigned* bar; unsigned x;
    volatile LAS unsigned* st;
};

__device__ __forceinline__ XcdBarrier xcd_barrier_post(unsigned* bar, volatile LAS unsigned* st, bool t0) {
    XcdBarrier b; b.bar = bar; b.x = xb_xcc_id(); b.st = st;
    if (t0) (void)xb_add(&bar[XB_XCNT(b.x)], 1u);
    return b;
}
__device__ __forceinline__ void xcd_barrier_complete(unsigned* bar, unsigned x, unsigned& nloc, unsigned& nx) {
    const unsigned G = gridDim.x * gridDim.y * gridDim.z;
    unsigned sum, cnt, mine, sp = 0u;
    for (;;) {
        sum = 0u; cnt = 0u; mine = 0u;
#pragma unroll
        for (unsigned j = 0; j < 16; ++j) { const unsigned c = xb_ld(&bar[XB_XCNT(j)]); sum += c; cnt += (c > 0u) ? 1u : 0u; mine = (j == x) ? c : mine; }
        if (sum == G) break;
        __builtin_amdgcn_s_sleep(1);
        if ((++sp & 255u) == 0u) { if (xb_ld(&bar[XB_TMO])) break; if (sp > XB_SPIN_CAP) { atomicAdd(&bar[XB_TMO], 1u); break; } }
    }
    nloc = mine > 0u ? mine : 1u; nx = cnt > 0u ? cnt : 1u;
}

__device__ __forceinline__ void xcd_barrier(const XcdBarrier& b, bool t0) {
    asm volatile("s_waitcnt vmcnt(0)" ::: "memory");
    __syncthreads();
    if (t0) {
        unsigned* bar = b.bar;
        __builtin_amdgcn_s_waitcnt(0);
        unsigned nloc = b.st[0], nx = b.st[1];
        if (nloc == 0u) { xcd_barrier_complete(bar, b.x, nloc, nx); b.st[0] = nloc; b.st[1] = nx; }
        const unsigned old = xb_add(&bar[XB_XSUB(b.x)], 1u);
        const unsigned gen = old / nloc;
        if (old + 1u == (gen + 1u) * nloc) {
            __builtin_amdgcn_fence(__ATOMIC_RELEASE, "agent");
            asm volatile("s_waitcnt vmcnt(0)" ::: "memory");
            const unsigned og = xb_add(&bar[XB_TOP], 1u);
            const unsigned tg = og / nx;
            if (og + 1u == (tg + 1u) * nx) xb_add(&bar[XB_TOPGEN], 1u);
            else XB_SPIN(xb_ld(&bar[XB_TOPGEN]) == tg, bar);
            __builtin_amdgcn_fence(__ATOMIC_ACQUIRE, "agent");
            xb_add(&bar[XB_XGEN(b.x)], 1u);
            asm volatile("s_waitcnt vmcnt(0)" ::: "memory");
        } else {
            XB_SPIN(xb_ld(&bar[XB_XGEN(b.x)]) == gen, bar);
            __builtin_amdgcn_fence(__ATOMIC_ACQUIRE, "agent");
            asm volatile("s_waitcnt vmcnt(0)" ::: "memory");
        }
    }
    __syncthreads();
}
struct Args {
    const float *x, *c, *ctx, *c_ctx, *norm_g, *ada_w, *ada_b, *hy_w_in, *hy_conv_w, *hy_conv_b, *fw1, *fb1, *fw2, *fb2, *fw3, *fb3, *fw4, *freq, *hy_d, *hy_w_out,
                *at_w_in, *at_q_g, *at_k_g, *at_w_out;
    float* out; unsigned char* ws;
};

template <int MODE> __device__ __forceinline__ int dest_row(int n) {
    if (MODE == 1) { const int s = n >> 11, c = n & 2047, pn = c >> 6, cl = c & 63; return pn * 256 + 128 * (s >> 1) + 32 * (cl >> 4) + 8 * ((cl >> 2) & 3) + 4 * (s & 1) + (cl & 3); }
    if (MODE == 2) { if (n >= 2560) return n; const int hh = n >> 7, dim = n & 127, quarter = dim >> 5, rem = dim & 31;
        return hh * 128 + 32 * (rem >> 3) + 8 * ((rem >> 1) & 3) + 4 * (quarter >> 1) + 2 * (quarter & 1) + (rem & 1); }
    return n;
}
template <int MODE> __device__ __forceinline__ void transpose_item(const float* W, int K, int N, bf16_t* WT, LAS float* scr, int item, int lane) {
    const int nblk = N / 32, kb = item / nblk, nb = item % nblk, k0 = 64 * kb, n0 = 32 * nb;
    float tv[32];
#pragma unroll
    for (int i = 0; i < 32; ++i) { const int kk = 2 * i + (lane >> 5); tv[i] = W[(size_t)(k0 + kk) * N + n0 + (lane & 31)]; }
#pragma unroll
    for (int i = 0; i < 32; ++i) { const int kk = 2 * i + (lane >> 5); scr[kk * 33 + (lane & 31)] = tv[i]; }
    asm volatile("s_waitcnt lgkmcnt(0)" ::: "memory");
    const int c = lane & 7;
#pragma unroll
    for (int j = 0; j < 4; ++j) { const int n = (lane >> 3) + 8 * j; const LAS float* s = scr + (8 * c) * 33 + n;
        u32x4 o; o.x = pk2(s[0 * 33], s[1 * 33]); o.y = pk2(s[2 * 33], s[3 * 33]); o.z = pk2(s[4 * 33], s[5 * 33]); o.w = pk2(s[6 * 33], s[7 * 33]);
        *(u32x4*)(WT + (size_t)dest_row<MODE>(n0 + n) * K + k0 + 8 * c) = o; }
    asm volatile("s_waitcnt lgkmcnt(0)" ::: "memory");
}
__device__ __forceinline__ float red_rev(float x) { const float n = rintf(x * 0.15915494309189535f); float r = fmaf(n, -6.28125f, x); r = fmaf(n, -0.0019353071795864769f, r); return r * 0.15915494309189535f; }
__device__ __forceinline__ float hsin(float x) { return __builtin_amdgcn_sinf(red_rev(x)); }
__device__ __forceinline__ float hcos(float x) { return __builtin_amdgcn_cosf(red_rev(x)); }
__device__ __forceinline__ float rdlane(float v, int k) { return __builtin_bit_cast(float, __builtin_amdgcn_readlane(__builtin_bit_cast(int, v), k)); }
__device__ __forceinline__ void filt_item(const LAS float* fl, int L, int i, bf16_t* orow, int lane) {
    const float t = (float)i / (float)(L - 1);
    const float w = 6.283185307179586f * (float)i / (float)L;
    float zf = 0.f;
    if (lane == 0) zf = t;
    else if (lane <= 32) { const int mi = (lane - 1) & 15; const float fr = 1e-4f + (float)mi * ((15.0f - 1e-4f) / 15.0f); zf = (lane <= 16) ? hcos(fr * w) : -hsin(fr * w); }
    const float fq = fl[10496 + lane];
    float a = fl[10304 + lane];
#pragma unroll 3
    for (int k = 0; k < 33; ++k) a += rdlane(zf, k) * fl[k * 64 + lane];
    float h = hsin(fq * a);
    a = fl[10368 + lane];
#pragma unroll 8
    for (int k = 0; k < 64; ++k) a += rdlane(h, k) * fl[2112 + k * 64 + lane];
    h = hsin(fq * a);
    a = fl[10432 + lane];
#pragma unroll 8
    for (int k = 0; k < 64; ++k) a += rdlane(h, k) * fl[6208 + k * 64 + lane];
    h = hsin(fq * a);
    const unsigned hi = f2bf(h); const unsigned lo = f2bf(h - bf2f((unsigned short)hi));
    orow[lane] = (bf16_t)hi; orow[64 + lane] = (bf16_t)lo; orow[128 + lane] = (bf16_t)hi; orow[192 + lane] = 0;
}
__device__ __forceinline__ void w4x_item(const float* W4, bf16_t* W4X, LAS float* scr, int item, int lane) {
    const int n0 = 32 * item;
    float tv[32];
#pragma unroll
    for (int i = 0; i < 32; ++i) { const int kk = 2 * i + (lane >> 5); tv[i] = W4[(size_t)kk * 4096 + n0 + (lane & 31)]; }
#pragma unroll
    for (int i = 0; i < 32; ++i) { const int kk = 2 * i + (lane >> 5); scr[kk * 33 + (lane & 31)] = tv[i]; }
    asm volatile("s_waitcnt lgkmcnt(0)" ::: "memory");
    const int seg = lane >> 4, kb = (4 * lane) & 63;
    for (int n = 0; n < 32; ++n) {
        unsigned hv[4];
#pragma unroll
        for (int j = 0; j < 4; ++j) { const float x = scr[(kb + j) * 33 + n]; const unsigned hi = f2bf(x); const unsigned lo = f2bf(x - bf2f((unsigned short)hi)); hv[j] = seg < 2 ? hi : (seg == 2 ? lo : 0u); }
        u32x2 o; o.x = hv[0] | (hv[1] << 16); o.y = hv[2] | (hv[3] << 16);
        *(u32x2*)(W4X + (size_t)(n0 + n) * 256 + 4 * lane) = o;
    }
    asm volatile("s_waitcnt lgkmcnt(0)" ::: "memory");
}
__device__ __forceinline__ void norm_row_v(const f32x4 (&v)[4], const float* g, const float* mod, bf16_t* orow, int lane) {
    float s = 0.f;
#pragma unroll
    for (int j = 0; j < 4; ++j) s += (v[j].x * v[j].x + v[j].y * v[j].y) + (v[j].z * v[j].z + v[j].w * v[j].w);
    const float rstd = rsqrtf(wave_sum(s) * (1.f / DM) + EPSN);
#pragma unroll
    for (int j = 0; j < 4; ++j) { const int col = 4 * lane + 256 * j;
        const f32x4 gg = *(const f32x4*)(g + col), sh = *(const f32x4*)(mod + col), sc = *(const f32x4*)(mod + 1024 + col);
        const f32x4 h = v[j] * rstd * gg * (1.f + sc) + sh;
        u32x2 o; o.x = pk2(h.x, h.y); o.y = pk2(h.z, h.w); *(u32x2*)(orow + col) = o; }
}
__device__ __forceinline__ void norm_row(const float* xrow, const float* g, const float* mod, bf16_t* orow, int lane) {
    f32x4 v[4];
#pragma unroll
    for (int j = 0; j < 4; ++j) v[j] = ((const f32x4*)xrow + lane)[64 * j];
    norm_row_v(v, g, mod, orow, lane);
}
__device__ __forceinline__ void norm_row_ctx(const float* xrow, const float* part, const float* gt, const float* g, const float* mod, bf16_t* orow, int lane) {
    f32x4 v[4]; float s = 0.f;
#pragma unroll
    for (int j = 0; j < 4; ++j) { const int col = 4 * lane + 256 * j; f32x4 a = *(const f32x4*)(part + col);
#pragma unroll
        for (int ks = 1; ks < 8; ++ks) a += *(const f32x4*)(part + (size_t)ks * 512 * DM + col);
        v[j] = *(const f32x4*)(xrow + col) + *(const f32x4*)(gt + col) * a;
        s += (v[j].x * v[j].x + v[j].y * v[j].y) + (v[j].z * v[j].z + v[j].w * v[j].w); }
    const float rstd = rsqrtf(wave_sum(s) * (1.f / DM) + EPSN);
#pragma unroll
    for (int j = 0; j < 4; ++j) { const int col = 4 * lane + 256 * j;
        const f32x4 gg = *(const f32x4*)(g + col), sh = *(const f32x4*)(mod + col), sc = *(const f32x4*)(mod + 1024 + col);
        const f32x4 h = v[j] * rstd * gg * (1.f + sc) + sh;
        u32x2 o; o.x = pk2(h.x, h.y); o.y = pk2(h.z, h.w); *(u32x2*)(orow + col) = o; }
}

typedef float cf __attribute__((ext_vector_type(2)));
__device__ __forceinline__ cf cmul(cf a, cf b) { return {a.x * b.x - a.y * b.y, a.x * b.y + a.y * b.x}; }
template <int SGN> __device__ __forceinline__ cf mulw4(cf a) { return SGN > 0 ? cf{-a.y, a.x} : cf{a.y, -a.x}; }
template <int SGN> __device__ __forceinline__ void fft4(cf& a0, cf& a1, cf& a2, cf& a3) {
    const cf s02 = a0 + a2, d02 = a0 - a2, s13 = a1 + a3, d13 = mulw4<SGN>(a1 - a3);
    a0 = s02 + s13; a1 = d02 + d13; a2 = s02 - s13; a3 = d02 - d13;
}
template <int SGN> __device__ __forceinline__ cf tw(float frac) { return {__builtin_amdgcn_cosf(frac), (float)SGN * __builtin_amdgcn_sinf(frac)}; }
template <int SGN> __device__ __forceinline__ void fft16(cf (&v)[16]) {
#pragma unroll
    for (int b = 0; b < 4; ++b) fft4<SGN>(v[b], v[4 + b], v[8 + b], v[12 + b]);
    constexpr float C1 = 0.92387953251128674f, S1 = 0.38268343236508977f, C2 = 0.70710678118654752f;
    const float sg = (float)SGN;
    v[4 * 1 + 1] = cmul(v[4 * 1 + 1], cf{C1, sg * S1});
    v[4 * 1 + 2] = cmul(v[4 * 1 + 2], cf{C2, sg * C2});
    v[4 * 1 + 3] = cmul(v[4 * 1 + 3], cf{S1, sg * C1});
    v[4 * 2 + 1] = cmul(v[4 * 2 + 1], cf{C2, sg * C2});
    v[4 * 2 + 2] = mulw4<SGN>(v[4 * 2 + 2]);
    v[4 * 2 + 3] = cmul(v[4 * 2 + 3], cf{-C2, sg * C2});
    v[4 * 3 + 1] = cmul(v[4 * 3 + 1], cf{S1, sg * C1});
    v[4 * 3 + 2] = cmul(v[4 * 3 + 2], cf{-C2, sg * C2});
    v[4 * 3 + 3] = cmul(v[4 * 3 + 3], cf{-C1, -sg * S1});
#pragma unroll
    for (int c = 0; c < 4; ++c) fft4<SGN>(v[4 * c + 0], v[4 * c + 1], v[4 * c + 2], v[4 * c + 3]);
}
template <int SGN, int STRIDE> __device__ __forceinline__ void fft32_store(const cf (&t)[32], LAS cf* Lw) {
    constexpr float C32[16] = {1.f, 0.98078528040323043f, 0.92387953251128674f, 0.83146961230254524f, 0.70710678118654752f, 0.55557023301960218f, 0.38268343236508977f, 0.19509032201612825f,
                               0.f, -0.19509032201612825f, -0.38268343236508977f, -0.55557023301960218f, -0.70710678118654752f, -0.83146961230254524f, -0.92387953251128674f, -0.98078528040323043f};
    constexpr float S32[16] = {0.f, 0.19509032201612825f, 0.38268343236508977f, 0.55557023301960218f, 0.70710678118654752f, 0.83146961230254524f, 0.92387953251128674f, 0.98078528040323043f,
                               1.f, 0.98078528040323043f, 0.92387953251128674f, 0.83146961230254524f, 0.70710678118654752f, 0.55557023301960218f, 0.38268343236508977f, 0.19509032201612825f};
    cf te[16], to[16];
#pragma unroll
    for (int q = 0; q < 16; ++q) { te[q] = t[2 * q]; to[q] = t[2 * q + 1]; }
    fft16<SGN>(te); fft16<SGN>(to);
#pragma unroll
    for (int k = 0; k < 16; ++k) { const int idx = 4 * (k & 3) + (k >> 2);
        const cf o = (k == 0) ? to[idx] : cmul(to[idx], cf{C32[k], (float)SGN * S32[k]});
        Lw[STRIDE * k] = te[idx] + o; Lw[STRIDE * (k + 16)] = te[idx] - o; }
}
template <int SGN> __device__ __forceinline__ void fft_run(cf (&v)[32], LAS cf* L, int tid) {
    asm volatile("" : "+v"(tid));
    const int pb = tid + (tid >> 5);
    fft32_store<SGN, 1>(v, L + 33 * tid);
    __syncthreads();
#pragma unroll
    for (int q = 0; q < 32; ++q) v[q] = L[pb + 528 * q];
    __syncthreads();
    { const int jm = tid & 31; const float f1 = (float)jm * (1.0f / 1024.0f);
#pragma unroll
      for (int q = 1; q < 32; ++q) v[q] = cmul(v[q], tw<SGN>(f1 * (float)q));
      const int base = (tid >> 5) * 1024 + jm;
      fft32_store<SGN, 33>(v, L + base + (base >> 5)); }
    __syncthreads();
#pragma unroll
    for (int i = 0; i < 2; ++i) { const int j = tid + 512 * i; const float f1 = (float)j * (1.0f / 16384.0f);
        cf t[16];
#pragma unroll
        for (int q = 0; q < 16; ++q) t[q] = L[pb + 528 * i + 1056 * q];
#pragma unroll
        for (int q = 1; q < 16; ++q) t[q] = cmul(t[q], tw<SGN>(f1 * (float)q));
        fft16<SGN>(t);
#pragma unroll
        for (int p = 0; p < 16; ++p) v[i + 2 * p] = t[4 * (p & 3) + (p >> 2)];
        __builtin_amdgcn_sched_barrier(0); }
    __syncthreads();
}
__device__ __forceinline__ float block_sum(float v, LAS float* red, int tid) {
    v = wave_sum(v);
    if ((tid & 63) == 0) red[tid >> 6] = v;
    __syncthreads();
    float s = 0.f;
#pragma unroll
    for (int i = 0; i < 8; ++i) s += red[i];
    __syncthreads();
    return s;
}
#ifndef DBL
#define DBL 0
#endif
__device__ __forceinline__ const Args& kargs_ref() {
#if defined(__HIP_DEVICE_COMPILE__)
    typedef const __attribute__((address_space(4))) Args* KArgP;
    KArgP p = (KArgP)__builtin_amdgcn_kernarg_segment_ptr(); asm volatile("" : "+s"(p)); return *(const Args*)p;
#else
    static Args dummy; return dummy;
#endif
}
__global__ void __launch_bounds__(NTHR, 2) mk_fwd(Args Akern) {
    extern __shared__ __attribute__((aligned(16))) unsigned char lds_raw[];
    cg::grid_group grid = cg::this_grid();
    LAS unsigned char* lds = (LAS unsigned char*)lds_raw;
    const int G = gridDim.x, bx = blockIdx.x;
    const int wave_s = __builtin_amdgcn_readfirstlane((int)threadIdx.x >> 6);
    if (threadIdx.x < 2) ((LAS unsigned*)(lds + LDS_MISC))[threadIdx.x] = 0u;
    __syncthreads();
    (void)xcd_barrier_post((unsigned*)(kargs_ref().ws + WS_CTL), (volatile LAS unsigned*)(lds + LDS_MISC), threadIdx.x == 0);
#define GRID_BAR() do { int tb_; asm volatile("v_mbcnt_lo_u32_b32 %0, -1, 0\n\tv_mbcnt_hi_u32_b32 %0, -1, %0" : "=v"(tb_)); XcdBarrier xb_; xb_.bar = (unsigned*)(kargs_ref().ws + WS_CTL); xb_.x = xb_xcc_id(); \
        xb_.st = (volatile LAS unsigned*)(lds + LDS_MISC); xcd_barrier(xb_, wave_s == 0 && tb_ == 0); } while (0)
#define MOD ((float*)(ws + WS_MOD))
#define H3X ((bf16_t*)(ws + WS_H3X))
#define W4X ((bf16_t*)(ws + WS_W4X))
#define ROPE ((float*)(ws + WS_ROPE))
#define KTC ((float*)(ws + WS_KTC))
#define X1C ((float*)(ws + WS_X1C))
#define WIN ((bf16_t*)(ws + WS_WIN))
#define WOUT ((bf16_t*)(ws + WS_WOUT))
#define AWIN ((bf16_t*)(ws + WS_AWIN))
#define AWOUT ((bf16_t*)(ws + WS_AWOUT))
#define H ((bf16_t*)(ws + WS_H))
#define S ((float*)(ws + WS_S))
#define UT ((bf16_t*)(ws + WS_UT))
#define GB ((bf16_t*)(ws + WS_G))
#define Q ((bf16_t*)(ws + WS_Q))
#define ZS ((bf16_t*)(ws + WS_ZS))
#define KB ((bf16_t*)(ws + WS_KB))
#define VB ((bf16_t*)(ws + WS_VB))
#define KT ((bf16_t*)A.out)
#ifdef PROBE_K
#define STAMP(k) do { if (bx == 0 && threadIdx.x == 0) ((unsigned long long*)(kargs_ref().ws + 8192))[k] = __builtin_amdgcn_s_memrealtime(); } while (0)
#else
#define STAMP(k) do { } while (0)
#endif
    STAMP(0);
    _Pragma("unroll") for (int rep_ = 0; rep_ < ((((DBL) >> 0) & 1) ? 2 : 1); ++rep_) { if (rep_) GRID_BAR();
        const Args& A = kargs_ref(); unsigned char* ws = A.ws; int tid_; asm volatile("v_mbcnt_lo_u32_b32 %0, -1, 0\n\tv_mbcnt_hi_u32_b32 %0, -1, %0" : "=v"(tid_)); tid_ += wave_s * 64; const int tid = tid_, lane = tid & 63, wave = __builtin_amdgcn_readfirstlane(tid >> 6), gw = bx * 8 + wave, NGW = G * 8; (void)lane; (void)gw; (void)NGW;
        LAS float* scr = (LAS float*)(lds + wave * 8448);
        LAS float* fl = (LAS float*)(lds + 73728);
        for (int e2 = tid; e2 < 2112; e2 += NTHR) fl[e2] = A.fw1[e2];
        for (int e2 = tid; e2 < 4096; e2 += NTHR) { fl[2112 + e2] = A.fw2[e2]; fl[6208 + e2] = A.fw3[e2]; }
        if (tid < 64) { fl[10304 + tid] = A.fb1[tid]; fl[10368 + tid] = A.fb2[tid]; fl[10432 + tid] = A.fb3[tid]; fl[10496 + tid] = A.freq[tid]; }
        __syncthreads();
        constexpr int I0 = 16 * 256, I1 = 16 * 160, I2 = 32 * 32, I3 = 32 * 32, I4 = 128;
        for (int it = gw; it < I0 + I1 + I2 + I3 + I4; it += NGW) {
            int r = it;
            if (r < I0) { transpose_item<1>(A.hy_w_in, 1024, 8192, WIN, scr, r, lane); continue; } r -= I0;
            if (r < I1) { transpose_item<2>(A.at_w_in, 1024, 5120, AWIN, scr, r, lane); continue; } r -= I1;
            if (r < I2) { transpose_item<0>(A.hy_w_out, 2048, 1024, WOUT, scr, r, lane); continue; } r -= I2;
            if (r < I3) { transpose_item<0>(A.at_w_out, 2048, 1024, AWOUT, scr, r, lane); continue; } r -= I3;
            w4x_item(A.fw4, W4X, scr, r, lane);
        }
        for (int it = gw; it < LSEQ + CTX; it += NGW) filt_item(fl, it < LSEQ ? LSEQ : CTX, it < LSEQ ? it : it - LSEQ, H3X + (size_t)it * 256, lane);
        for (int it = bx * NTHR + tid; it < 128 * 32; it += G * NTHR) { const int pos = it >> 5, f = it & 31; const float inv = __builtin_amdgcn_exp2f(-(float)f * (13.287712379549449f / 32.0f)); const float ang = (float)pos * inv;
            ROPE[it * 2] = hcos(ang); ROPE[it * 2 + 1] = hsin(ang); }
        __syncthreads();
        if (bx < 96) {
            LAS float* sl = (LAS float*)lds;
            LAS float* part = (LAS float*)(lds + 16384);
            for (int e2 = tid; e2 < 3072; e2 += NTHR) { const int k = e2 & 1023; sl[e2] = silu_f(e2 < 2048 ? A.c[e2] : A.c_ctx[k]); }
            __syncthreads();
            for (int it = bx; it < 96; it += G) {
                const int l = it / 48, n = (it % 48) * 64 + lane;
                const float* W = A.ada_w + (size_t)l * 1024 * 3072 + n;
                float a0 = 0.f, a1 = 0.f, a2 = 0.f;
#pragma unroll 32
                for (int k = wave * 128; k < wave * 128 + 128; ++k) { const float wv = W[(size_t)k * 3072]; a0 += sl[k] * wv; a1 += sl[1024 + k] * wv; a2 += sl[2048 + k] * wv; }
                part[(wave * 3 + 0) * 64 + lane] = a0; part[(wave * 3 + 1) * 64 + lane] = a1; part[(wave * 3 + 2) * 64 + lane] = a2;
                __syncthreads();
                if (wave < 3) { float s = A.ada_b[l * 3072 + n];
#pragma unroll
                    for (int w8 = 0; w8 < 8; ++w8) s += part[(w8 * 3 + wave) * 64 + lane];
                    MOD[(l * 3 + wave) * 3072 + n] = s; }
                __syncthreads();
            }
        }
    }
    if (gridDim.y == 0x7fffffffu) grid.sync();
    GRID_BAR();
    STAMP(1);
    _Pragma("unroll") for (int rep_ = 0; rep_ < ((((DBL) >> 1) & 1) ? 2 : 1); ++rep_) { if (rep_) GRID_BAR();
        const Args& A = kargs_ref(); unsigned char* ws = A.ws; int tid_; asm volatile("v_mbcnt_lo_u32_b32 %0, -1, 0\n\tv_mbcnt_hi_u32_b32 %0, -1, %0" : "=v"(tid_)); tid_ += wave_s * 64; const int tid = tid_, lane = tid & 63, wave = __builtin_amdgcn_readfirstlane(tid >> 6), gw = bx * 8 + wave, NGW = G * 8; (void)lane; (void)gw; (void)NGW;
        { f32x4 v[4], vn[4];
#define XROW(m_) ((m_) < MLAT ? A.x + (size_t)(m_) * DM : A.ctx + (size_t)((m_) - MLAT) * DM)
          if (gw < MALL) {
#pragma unroll
              for (int j = 0; j < 4; ++j) v[j] = ((const f32x4*)XROW(gw) + lane)[64 * j]; }
          for (int m = gw; m < MALL; m += NGW) { const int src = m < LSEQ ? 0 : (m < MLAT ? 1 : 2), mn = m + NGW;
              if (mn < MALL) {
#pragma unroll
                  for (int j = 0; j < 4; ++j) vn[j] = ((const f32x4*)XROW(mn) + lane)[64 * j]; }
              norm_row_v(v, A.norm_g, MOD + src * 3072, H + (size_t)m * DM, lane);
#pragma unroll
              for (int j = 0; j < 4; ++j) v[j] = vn[j]; }
#undef XROW
        }
    }
    GRID_BAR();
    STAMP(2);
    _Pragma("unroll") for (int rep_ = 0; rep_ < ((((DBL) >> 2) & 1) ? 2 : 1); ++rep_) { if (rep_) GRID_BAR();
        const Args& A = kargs_ref(); unsigned char* ws = A.ws; int tid_; asm volatile("v_mbcnt_lo_u32_b32 %0, -1, 0\n\tv_mbcnt_hi_u32_b32 %0, -1, %0" : "=v"(tid_)); tid_ += wave_s * 64; const int tid = tid_, lane = tid & 63, wave = __builtin_amdgcn_readfirstlane(tid >> 6), gw = bx * 8 + wave, NGW = G * 8; (void)lane; (void)gw; (void)NGW;
        pg8::Gemm g{H, WIN, MALL, 8192, 1024}; int bxl = bx, Gl = G; asm volatile("" : "+s"(bxl), "+s"(Gl)); pg8::StaticOrder So; So.init(MALL, 8192, Gl, bxl, 1024);
        pg8::EpiHy E{A.hy_conv_w, A.hy_conv_b, UT, GB, S, lds + LDS_XCH};
        pg8::gemm_phase<pg8::EpiHy, pg8::StaticOrder, true, true>(lds, g, So, E, tid_);
        { const int nun = (MALL / 256) * (8192 / 256), rem = nun % Gl; const bool all = (rem == 0);
          if (all || bxl >= rem) {
              pg8::Gemm g2{W4X, H3X, 4096, LSEQ + CTX, 256}; pg8::StaticOrder So2; So2.init(4096, LSEQ + CTX, all ? Gl : Gl - rem, all ? bxl : bxl - rem, 256);
              pg8::EpiKgen E2{KT, KTC};
              pg8::gemm_phase<pg8::EpiKgen, pg8::StaticOrder, true, true>(lds, g2, So2, E2, tid_); } }
    }
    GRID_BAR();
    STAMP(3);
    _Pragma("unroll") for (int rep_ = 0; rep_ < ((((DBL) >> 3) & 1) ? 2 : 1); ++rep_) { if (rep_) GRID_BAR();
        const Args& A = kargs_ref(); unsigned char* ws = A.ws; int tid_; asm volatile("v_mbcnt_lo_u32_b32 %0, -1, 0\n\tv_mbcnt_hi_u32_b32 %0, -1, %0" : "=v"(tid_)); tid_ += wave_s * 64; const int tid = tid_, lane = tid & 63, wave = __builtin_amdgcn_readfirstlane(tid >> 6), gw = bx * 8 + wave, NGW = G * 8; (void)lane; (void)gw; (void)NGW;
        for (int it = bx * NTHR + tid; it < NSTRIP * 2 * 512; it += G * NTHR) {
            const int c0 = (it & 511) * 4, ri = it >> 9, strip = ri >> 1, which = ri & 1;
            const int row = strip * 64 + (which ? 63 : 0);
            const bool seq_start = (row & (LSEQ - 1)) == 0 || (row >= MLAT && (row & 255) == 0);
            const bool seq_end = ((row + 1) & (LSEQ - 1)) == 0 || (row >= MLAT && ((row + 1) & 255) == 0);
            const float* Sp; const float* Sc; const float* Sn; bool zp = false, zn = false;
            if (which == 0) { zp = seq_start; Sp = S + (size_t)(((zp ? strip : strip - 1) * 4 + 3) * 4) * 2048; Sc = S + (size_t)((strip * 4 + 0) * 4) * 2048; Sn = S + (size_t)((strip * 4 + 1) * 4) * 2048; }
            else { zn = seq_end; Sp = S + (size_t)((strip * 4 + 2) * 4) * 2048; Sc = S + (size_t)((strip * 4 + 3) * 4) * 2048; Sn = S + (size_t)(((zn ? strip : strip + 1) * 4 + 0) * 4) * 2048; }
            f32x4 cv[3];
#pragma unroll
            for (int s = 0; s < 3; ++s) {
                f32x4 pv = *(const f32x4*)(Sp + s * 2048 + c0), cur = *(const f32x4*)(Sc + s * 2048 + c0), nx = *(const f32x4*)(Sn + s * 2048 + c0);
                if (zp) pv = (f32x4){0.f, 0.f, 0.f, 0.f}; if (zn) nx = (f32x4){0.f, 0.f, 0.f, 0.f};
                cv[s] = *(const f32x4*)(A.hy_conv_w + 0 * 6144 + s * 2048 + c0) * pv + *(const f32x4*)(A.hy_conv_w + 1 * 6144 + s * 2048 + c0) * cur
                      + *(const f32x4*)(A.hy_conv_w + 2 * 6144 + s * 2048 + c0) * nx + *(const f32x4*)(A.hy_conv_b + s * 2048 + c0);
            }
            const f32x4 z = *(const f32x4*)(Sc + 3 * 2048 + c0);
            const f32x4 uu = cv[1] * cv[2]; f32x4 g;
#pragma unroll
            for (int j = 0; j < 4; ++j) { g[j] = cv[0][j] * silu_f(z[j]); UT[(size_t)(c0 + j) * MALL + row] = (bf16_t)f2bf(uu[j]); }
            u32x2 gw2; gw2.x = pk2(g[0], g[1]); gw2.y = pk2(g[2], g[3]);
            *(u32x2*)(GB + (size_t)row * 2048 + c0) = gw2;
        }
    }
    GRID_BAR();
    STAMP(4);
    _Pragma("unroll") for (int rep_ = 0; rep_ < ((((DBL) >> 4) & 1) ? 2 : 1); ++rep_) { if (rep_) GRID_BAR();
        int dry = (((DBL) >> 4) & 1) && rep_ == 0; asm volatile("" : "+s"(dry));
        const Args& A = kargs_ref(); unsigned char* ws = A.ws; int tid_; asm volatile("v_mbcnt_lo_u32_b32 %0, -1, 0\n\tv_mbcnt_hi_u32_b32 %0, -1, %0" : "=v"(tid_)); tid_ += wave_s * 64; const int tid = tid_, lane = tid & 63, wave = __builtin_amdgcn_readfirstlane(tid >> 6), gw = bx * 8 + wave, NGW = G * 8; (void)lane; (void)gw; (void)NGW;
        LAS cf* L = (LAS cf*)lds; LAS float* red = (LAS float*)(lds + 139264); LAS float* Lf = (LAS float*)lds;
        unsigned short kraw[32];
#define P4_LOADK(chn) do { const bf16_t* kf_ = KT + (size_t)(chn) * 2 * LSEQ; const bf16_t* kb_ = kf_ + LSEQ; \
            _Pragma("unroll") for (int m = 0; m < 32; ++m) { const int pos = tid + 512 * m; int ix = 2 * LSEQ - pos; ix = ix > LSEQ - 1 ? LSEQ - 1 : ix; kraw[m] = (m < 16) ? kf_[pos] : kb_[ix]; } } while (0)
        { int tl = tid_; asm volatile("" : "+v"(tl));
#define tid tl
          if (bx < EH) P4_LOADK(bx);
#undef tid
        }
        for (int ch = bx; ch < EH; ch += G) {
            int tl = tid_; asm volatile("" : "+v"(tl));
#define tid tl
            cf v[32];
            bf16_t* u0 = UT + (size_t)ch * MALL;
            float asum = 0.f;
#pragma unroll
            for (int m = 0; m < 32; ++m) { float kv = bf2f(kraw[m]); if (m == 16) kv = (tid == 0) ? 0.f : kv; asum += fabsf(kv); v[m] = cf{kv, 0.f}; }
            unsigned short ura[16], urb[16];
#pragma unroll
            for (int m = 0; m < 16; ++m) { const int pos = tid + 512 * m; ura[m] = u0[pos]; urb[m] = u0[LSEQ + pos]; }
            { const float ws_ = wave_sum(asum); if ((tid & 63) == 0) red[tid >> 6] = ws_; }
            fft_run<-1>(v, L, tid);
            float tot = 0.f;
#pragma unroll
            for (int i8 = 0; i8 < 8; ++i8) tot += red[i8];
            const float sc = 1.0f / (tot * 16384.0f);
            f32x4* KS = (f32x4*)(ws + WS_S) + (size_t)bx * 8192 + tid;
#pragma unroll
            for (int m = 0; m < 32; m += 2) KS[512 * (m >> 1)] = (f32x4){v[m].x * sc, v[m].y * sc, v[m + 1].x * sc, v[m + 1].y * sc};
#pragma unroll
            for (int m = 0; m < 32; ++m) v[m] = (m < 16) ? cf{bf2f(ura[m]), bf2f(urb[m])} : cf{0.f, 0.f};
            fft_run<-1>(v, L, tid);
#pragma unroll
            for (int m = 0; m < 32; m += 2) { const f32x4 kk = KS[512 * (m >> 1)]; v[m] = cmul(v[m], cf{kk.x, kk.y}); v[m + 1] = cmul(v[m + 1], cf{kk.z, kk.w}); }
            asm volatile("" : "+v"(tl));
#pragma unroll
            for (int m = 0; m < 16; ++m) { const int pos = tid + 512 * m; ura[m] = u0[pos]; urb[m] = u0[LSEQ + pos]; }
            const unsigned short ucr = u0[MLAT + tid]; const float kc = KTC[(size_t)ch * 512 + tid];
            fft_run<1>(v, L, tid);
            asm volatile("" : "+v"(tl));
            const float dsk = A.hy_d[ch];
#pragma unroll
            for (int m = 0; m < 16; ++m) { const int pos = tid + 512 * m;
                if (!dry) { u0[pos] = (bf16_t)f2bf(v[m].x + dsk * bf2f(ura[m])); u0[LSEQ + pos] = (bf16_t)f2bf(v[m].y + dsk * bf2f(urb[m])); } }
            if (ch + G < EH) P4_LOADK(ch + G);
            const float uc = bf2f(ucr);
            Lf[tid] = uc; { const int dir = tid >> 8, tq = tid & 255; if (dir == 0) Lf[512 + 255 + tq] = kc; else if (tq > 0) Lf[512 + 255 - tq] = kc; }
            { const float ws_ = wave_sum((tid == 256) ? 0.f : fabsf(kc)); if ((tid & 63) == 0) red[8 + (tid >> 6)] = ws_; }
            __syncthreads();
            float acc;
            { const int t = tid & 255, s0 = (tid >> 8) * 128; const LAS float* kp = Lf + 512 + 255 + t - s0; const LAS float* up = Lf + s0; float a0 = 0.f, a1 = 0.f;
#pragma unroll 8
              for (int g = 0; g < 32; ++g) { const f32x4 ua4 = *(const LAS f32x4*)(up + 4 * g), ub4 = *(const LAS f32x4*)(up + 256 + 4 * g);
                  const float k0 = kp[-4 * g], k1 = kp[-4 * g - 1], k2 = kp[-4 * g - 2], k3 = kp[-4 * g - 3];
                  a0 += k0 * ua4.x + k1 * ua4.y + k2 * ua4.z + k3 * ua4.w; a1 += k0 * ub4.x + k1 * ub4.y + k2 * ub4.z + k3 * ub4.w; }
              LAS float* Lp = Lf + 1536;
              Lp[(tid >> 8) * 512 + t] = a0; Lp[(tid >> 8) * 512 + 256 + t] = a1;
              __syncthreads();
              acc = Lp[tid] + Lp[512 + tid]; }
            float totc = 0.f;
#pragma unroll
            for (int i8 = 0; i8 < 8; ++i8) totc += red[8 + i8];
            if (!dry) u0[MLAT + tid] = (bf16_t)f2bf(acc / totc + dsk * uc);
            __syncthreads();
#undef tid
        }
    }
    GRID_BAR();
    STAMP(5);
    _Pragma("unroll") for (int rep_ = 0; rep_ < ((((DBL) >> 5) & 1) ? 2 : 1); ++rep_) { if (rep_) GRID_BAR();
        const Args& A = kargs_ref(); unsigned char* ws = A.ws; int tid_; asm volatile("v_mbcnt_lo_u32_b32 %0, -1, 0\n\tv_mbcnt_hi_u32_b32 %0, -1, %0" : "=v"(tid_)); tid_ += wave_s * 64; const int tid = tid_, lane = tid & 63, wave = __builtin_amdgcn_readfirstlane(tid >> 6), gw = bx * 8 + wave, NGW = G * 8; (void)lane; (void)gw; (void)NGW;
        LAS bf16_t* T = (LAS bf16_t*)lds;
        const int chn = tid >> 3, rc = tid & 7, row = tid >> 3, cc = tid & 7;
        constexpr int NT5 = NSTRIP * 32;
        u32x4 q = {0u, 0u, 0u, 0u}, gq = {0u, 0u, 0u, 0u};
        if (bx < NT5) { const int r0 = (bx >> 5) * 64, c0 = (bx & 31) * 64; q = *(const u32x4*)(UT + (size_t)(c0 + chn) * MALL + r0 + 8 * rc); gq = *(const u32x4*)(GB + (size_t)(r0 + row) * 2048 + c0 + 8 * cc); }
        for (int it = bx; it < NT5; it += G) {
            const int r0 = (it >> 5) * 64, c0 = (it & 31) * 64, itn = it + G;
            u32x4 qn = q, gqn = gq;
            if (itn < NT5) { const int r1 = (itn >> 5) * 64, c1 = (itn & 31) * 64; qn = *(const u32x4*)(UT + (size_t)(c1 + chn) * MALL + r1 + 8 * rc); gqn = *(const u32x4*)(GB + (size_t)(r1 + row) * 2048 + c1 + 8 * cc); }
#pragma unroll
            for (int e2 = 0; e2 < 4; ++e2) { T[(8 * rc + 2 * e2) * 68 + chn] = (bf16_t)(q[e2] & 0xffffu); T[(8 * rc + 2 * e2 + 1) * 68 + chn] = (bf16_t)(q[e2] >> 16); }
            __syncthreads();
            { u32x4 o;
#pragma unroll
              for (int e2 = 0; e2 < 4; ++e2) { const float y0 = bf2f(T[row * 68 + 8 * cc + 2 * e2]), y1 = bf2f(T[row * 68 + 8 * cc + 2 * e2 + 1]);
                  o[e2] = pk2(y0 * bf2f((bf16_t)(gq[e2] & 0xffffu)), y1 * bf2f((bf16_t)(gq[e2] >> 16))); }
              *(u32x4*)(GB + (size_t)(r0 + row) * 2048 + c0 + 8 * cc) = o; }
            __syncthreads();
            q = qn; gq = gqn;
        }
    }
    GRID_BAR();
    STAMP(6);
    _Pragma("unroll") for (int rep_ = 0; rep_ < ((((DBL) >> 6) & 1) ? 2 : 1); ++rep_) { if (rep_) GRID_BAR();
        const Args& A = kargs_ref(); unsigned char* ws = A.ws; int tid_; asm volatile("v_mbcnt_lo_u32_b32 %0, -1, 0\n\tv_mbcnt_hi_u32_b32 %0, -1, %0" : "=v"(tid_)); tid_ += wave_s * 64; const int tid = tid_, lane = tid & 63, wave = __builtin_amdgcn_readfirstlane(tid >> 6), gw = bx * 8 + wave, NGW = G * 8; (void)lane; (void)gw; (void)NGW;
        pg8::Gemm g{GB, WOUT, MALL, 1024, 2048}; int bxl = bx, Gl = G; asm volatile("" : "+s"(bxl), "+s"(Gl)); pg8::OrderP6 So; So.init(Gl, bxl);
        pg8::EpiRes6 E{A.x, A.out, MOD, (float*)(ws + WS_UT)};
        pg8::gemm_phase<pg8::EpiRes6, pg8::OrderP6, true, true>(lds, g, So, E, tid_);
    }
    GRID_BAR();
    STAMP(7);
    _Pragma("unroll") for (int rep_ = 0; rep_ < ((((DBL) >> 7) & 1) ? 2 : 1); ++rep_) { if (rep_) GRID_BAR();
        const Args& A = kargs_ref(); unsigned char* ws = A.ws; int tid_; asm volatile("v_mbcnt_lo_u32_b32 %0, -1, 0\n\tv_mbcnt_hi_u32_b32 %0, -1, %0" : "=v"(tid_)); tid_ += wave_s * 64; const int tid = tid_, lane = tid & 63, wave = __builtin_amdgcn_readfirstlane(tid >> 6), gw = bx * 8 + wave, NGW = G * 8; (void)lane; (void)gw; (void)NGW;
        { f32x4 v[4], vn[4];
#pragma unroll
          for (int j = 0; j < 4; ++j) v[j] = ((const f32x4*)(A.out + (size_t)gw * DM) + lane)[64 * j];
          for (int m = gw; m < MLAT; m += NGW) { const int mn = m + NGW;
              if (mn < MLAT) {
#pragma unroll
                  for (int j = 0; j < 4; ++j) vn[j] = ((const f32x4*)(A.out + (size_t)mn * DM) + lane)[64 * j]; }
              norm_row_v(v, A.norm_g + DM, MOD + (3 + (m < LSEQ ? 0 : 1)) * 3072, H + (size_t)m * DM, lane);
#pragma unroll
              for (int j = 0; j < 4; ++j) v[j] = vn[j]; }
        }
        for (int m = gw; m < NB * CTX; m += NGW) norm_row_ctx(A.ctx + (size_t)m * DM, (const float*)(ws + WS_UT) + (size_t)m * DM, MOD + 2 * 3072 + 2048, A.norm_g + DM, MOD + 5 * 3072, H + (size_t)(MLAT + m) * DM, lane);
    }
    GRID_BAR();
    STAMP(8);
    _Pragma("unroll") for (int rep_ = 0; rep_ < ((((DBL) >> 8) & 1) ? 2 : 1); ++rep_) { if (rep_) GRID_BAR();
        const Args& A = kargs_ref(); unsigned char* ws = A.ws; int tid_; asm volatile("v_mbcnt_lo_u32_b32 %0, -1, 0\n\tv_mbcnt_hi_u32_b32 %0, -1, %0" : "=v"(tid_)); tid_ += wave_s * 64; const int tid = tid_, lane = tid & 63, wave = __builtin_amdgcn_readfirstlane(tid >> 6), gw = bx * 8 + wave, NGW = G * 8; (void)lane; (void)gw; (void)NGW;
        pg8::Gemm g{H, AWIN, MALL, 5120, 1024}; int bxl = bx, Gl = G; asm volatile("" : "+s"(bxl), "+s"(Gl)); pg8::StaticOrder So; So.init(MALL, 5120, Gl, bxl, 1024);
        pg8::EpiQKV E{A.at_q_g, A.at_k_g, ROPE, Q, KB, VB, ZS, (LAS float*)(lds + LDS_XCH)};
        pg8::gemm_phase<pg8::EpiQKV, pg8::StaticOrder, true, true>(lds, g, So, E, tid_);
    }
    GRID_BAR();
    STAMP(9);
    _Pragma("unroll") for (int rep_ = 0; rep_ < ((((DBL) >> 9) & 1) ? 2 : 1); ++rep_) { if (rep_) GRID_BAR();
        int dry = (((DBL) >> 9) & 1) && rep_ == 0; asm volatile("" : "+s"(dry));
        const Args& A = kargs_ref(); unsigned char* ws = A.ws; int tid_; asm volatile("v_mbcnt_lo_u32_b32 %0, -1, 0\n\tv_mbcnt_hi_u32_b32 %0, -1, %0" : "=v"(tid_)); tid_ += wave_s * 64; const int tid = tid_, lane = tid & 63, wave = __builtin_amdgcn_readfirstlane(tid >> 6), gw = bx * 8 + wave, NGW = G * 8; (void)lane; (void)gw; (void)NGW;
        float gmq = fmaxf(fabsf(A.at_q_g[lane]), fabsf(A.at_q_g[64 + lane])), gmk = fmaxf(fabsf(A.at_k_g[lane]), fabsf(A.at_k_g[64 + lane]));
#pragma unroll
        for (int o = 1; o < 64; o <<= 1) { gmq = fmaxf(gmq, __shfl_xor(gmq, o)); gmk = fmaxf(gmk, __shfl_xor(gmk, o)); }
        const float mnCv = -(128.0f * 1.02f) * gmq * gmk * (att::SCALE * 1.4426950408889634f);
        const float mnC = __builtin_bit_cast(float, __builtin_amdgcn_readfirstlane(__builtin_bit_cast(int, mnCv)));
#define P9_LOOP(SH) for (int un = bx; un < NB * 16 * 32; un += G) { \
            const int qb = un & 31, gq = (un >> 5) & 3, kvh = (un >> 7) & 3, b = un >> 9, h = kvh * 4 + gq; \
            const size_t qoff = ((size_t)(b * LSEQ + qb * 256)) * 2048 + h * 128, koff = ((size_t)(b * 4 + kvh) * SKV) * 128; \
            int t2; asm volatile("v_mbcnt_lo_u32_b32 %0, -1, 0\n\tv_mbcnt_hi_u32_b32 %0, -1, %0" : "=v"(t2)); t2 += wave_s * 64; \
            att::attn_dense_body<att::bf16, SH>(Q + qoff, KB + koff, VB + koff, ZS + qoff, SKV, (char*)lds_raw, t2, dry, mnC); }
        if (mnC < -100.0f) { P9_LOOP(true) } else { P9_LOOP(false) }
#undef P9_LOOP
    }
    GRID_BAR();
    STAMP(10);
    _Pragma("unroll") for (int rep_ = 0; rep_ < ((((DBL) >> 10) & 1) ? 2 : 1); ++rep_) { if (rep_) GRID_BAR();
        const Args& A = kargs_ref(); unsigned char* ws = A.ws; int tid_; asm volatile("v_mbcnt_lo_u32_b32 %0, -1, 0\n\tv_mbcnt_hi_u32_b32 %0, -1, %0" : "=v"(tid_)); tid_ += wave_s * 64; const int tid = tid_, lane = tid & 63, wave = __builtin_amdgcn_readfirstlane(tid >> 6), gw = bx * 8 + wave, NGW = G * 8; (void)lane; (void)gw; (void)NGW;
        pg8::Gemm g{ZS, AWOUT, MLAT, 1024, 2048}; int bxl = bx, Gl = G; asm volatile("" : "+s"(bxl), "+s"(Gl)); pg8::StaticOrder So; So.init(MLAT, 1024, Gl, bxl, 2048);
        pg8::EpiRes E{A.out, A.out, A.out, A.out, MOD + 3 * 3072};
        pg8::gemm_phase<pg8::EpiRes, pg8::StaticOrder, true, true>(lds, g, So, E, tid_);
    }
#ifdef PROBE_K
    GRID_BAR();
    STAMP(11);
    if (bx == 0 && threadIdx.x == 0) { const unsigned long long* ts = (const unsigned long long*)(kargs_ref().ws + 8192); __builtin_amdgcn_s_waitcnt(0);
        kargs_ref().out[0] = (float)(ts[PROBE_K + 1] - ts[PROBE_K]) * 0.01f; }
#endif
}

extern "C" void kernel_launch(void* const* d_in, const int* in_sizes, int n_in, void* d_out, int out_size, void* d_ws, size_t ws_size, hipStream_t stream) {
    static int grid = 0;
    if (grid == 0) {
        if (n_in != 24 || out_size != MLAT * DM || ws_size < WS_END) { fprintf(stderr, "kernel_launch: unexpected shapes (n_in %d out %d ws %zu)\n", n_in, out_size, ws_size); grid = -1; return; }
        int dev = 0, cus = 0, per_cu = 0;
        (void)hipGetDevice(&dev); (void)hipDeviceGetAttribute(&cus, hipDeviceAttributeMultiprocessorCount, dev);
        if (hipFuncSetAttribute((const void*)mk_fwd, hipFuncAttributeMaxDynamicSharedMemorySize, LDS_BYTES) != hipSuccess) { fprintf(stderr, "kernel_launch: hipFuncSetAttribute failed\n"); grid = -1; return; }
        if (hipOccupancyMaxActiveBlocksPerMultiprocessor(&per_cu, (const void*)mk_fwd, NTHR, LDS_BYTES) != hipSuccess || per_cu < 1) { fprintf(stderr, "kernel_launch: occupancy query says %d\n", per_cu); per_cu = 1; }
        (void)hipGetLastError();
        grid = cus;
    }
    if (grid < 0) return;
    if (hipMemsetAsync((char*)d_ws + WS_CTL, 0, CTL_ZERO_BYTES, stream) != hipSuccess) { fprintf(stderr, "kernel_launch: memset failed\n"); return; }
    Args a{};
    const float** p = (const float**)&a;
    for (int i = 0; i < 24; ++i) p[i] = (const float*)d_in[i];
    a.out = (float*)d_out; a.ws = (unsigned char*)d_ws;
    void* args[] = {&a};
    hipError_t e = hipLaunchCooperativeKernel((const void*)mk_fwd, dim3(grid), dim3(NTHR), args, LDS_BYTES, stream);
    if (e != hipSuccess) fprintf(stderr, "cooperative launch failed: %s (grid %d)\n", hipGetErrorString(e), grid);
}
```
